# Optimizing an MI355X kernel written in HIP

```python
import jax, jax.numpy as jnp
from jax import lax
import numpy as np

D_MODEL = 1024
BATCH = 1
SEQ = 16384
DEPTH = 4

GRID_W = 64
CTX_LEN = 256
N_MIXERS = 4
CTX_READERS = (0, 2)
N_PER_MIXER = tuple((DEPTH - k + N_MIXERS - 1) // N_MIXERS for k in range(N_MIXERS))
N_MOD = 9
D_FF = 2816
EPS = 1e-6
Q_BLOCK = 128
MLA_HEADS = 8
MLA_Q_LORA = 384
MLA_KV_LORA = 256
MLA_NOPE = 128
MLA_ROPE = 64
MLA_V = 128
MLA_SCALE = (MLA_NOPE + MLA_ROPE) ** -0.5
ROPE_BASE = 10000.0
ROPE_PAIRS_PER_AXIS = MLA_ROPE // 4
POOL_WINDOWS = (2, 4, 8, 16)
POOL_GROUPS = 4
POOL_GROUP = D_MODEL // POOL_GROUPS
NA_HEADS = 16
NA_HEAD_DIM = D_MODEL // NA_HEADS
NA_ROWS = 8
NA_COLS = 16
NA_SCALE = NA_HEAD_DIM ** -0.5
CONV_WIDTH = 3

kernel_name = "hybrid_interleaved_diffusion_trunk"


def rms_norm(x):
    xf = x.astype(jnp.float32)
    return (xf * lax.rsqrt(jnp.mean(xf * xf, axis=-1, keepdims=True) + EPS)).astype(x.dtype)


def modulate(x, shift, scale):
    return rms_norm(x) * (1 + scale) + shift


def ada_params(cond, w, b):
    m = jax.nn.silu(cond) @ w + b
    return jnp.split(m[:, None, :], N_MOD, axis=-1)


def swiglu(h, w_in, w_out):
    g, u = jnp.split(h @ w_in, 2, axis=-1)
    return (jax.nn.silu(g) * u) @ w_out


def axial_rope_angles(T):
    t = jnp.arange(T)
    row = (t // GRID_W).astype(jnp.float32)
    col = (t % GRID_W).astype(jnp.float32)
    freqs = ROPE_BASE ** (-jnp.arange(ROPE_PAIRS_PER_AXIS, dtype=jnp.float32) / ROPE_PAIRS_PER_AXIS)
    return jnp.concatenate([row[:, None] * freqs, col[:, None] * freqs], axis=-1)


def rope_2d(x, ang):
    shape = (1, ang.shape[0]) + (1,) * (x.ndim - 3) + (ang.shape[1],)
    cos = jnp.cos(ang).reshape(shape)
    sin = jnp.sin(ang).reshape(shape)
    xp = x.astype(jnp.float32).reshape(x.shape[:-1] + (-1, 2))
    x0, x1 = xp[..., 0], xp[..., 1]
    out = jnp.stack([x0 * cos - x1 * sin, x0 * sin + x1 * cos], axis=-1)
    return out.reshape(x.shape).astype(x.dtype)


def mla_attention(qn, qr, kn, kr, v):
    B, T, H, _ = qn.shape
    blk = min(Q_BLOCK, T)
    nb = T // blk

    def to_blocks(a):
        return jnp.moveaxis(a.reshape((B, nb, blk) + a.shape[2:]), 1, 0)

    def one_block(qs):
        qn_b, qr_b = qs
        s = (jnp.einsum('bqhd,bkhd->bhqk', qn_b, kn) + jnp.einsum('bqhr,bkr->bhqk', qr_b, kr)) * MLA_SCALE
        p = jax.nn.softmax(s.astype(jnp.float32), axis=-1).astype(v.dtype)
        return jnp.einsum('bhqk,bkhd->bqhd', p, v)

    o = lax.map(one_block, (to_blocks(qn), to_blocks(qr)))
    return jnp.moveaxis(o, 0, 1).reshape(B, T, H * MLA_V)


def mla_mixer(hx, hc, ang, ctx_out, w_dq, g_dq, w_uq, w_dkv, g_dkv, w_uk, w_uv, g_qn, g_qr, g_kn, g_kr, w_o):
    def queries(h):
        cq = rms_norm(h @ w_dq) * g_dq
        q = jnp.einsum('btr,rhd->bthd', cq, w_uq)
        return rms_norm(q[..., :MLA_NOPE]) * g_qn, rms_norm(q[..., MLA_NOPE:]) * g_qr

    def keys_values(h):
        kv = h @ w_dkv
        ckv = rms_norm(kv[..., :MLA_KV_LORA]) * g_dkv
        kn = rms_norm(jnp.einsum('btr,rhd->bthd', ckv, w_uk)) * g_kn
        kr = rms_norm(kv[..., MLA_KV_LORA:]) * g_kr
        v = jnp.einsum('btr,rhd->bthd', ckv, w_uv)
        return kn, kr, v

    qn, qr = queries(hx)
    qr = rope_2d(qr, ang)
    kn, kr, v = keys_values(hx)
    kr = rope_2d(kr, ang)
    kn_c, kr_c, v_c = keys_values(hc)
    o = mla_attention(qn, qr,
                      jnp.concatenate([kn_c, kn], axis=1),
                      jnp.concatenate([kr_c, kr], axis=1),
                      jnp.concatenate([v_c, v], axis=1))
    yx = o @ w_o
    yc = None
    if ctx_out:
        qn_c, qr_c = queries(hc)
        yc = mla_attention(qn_c, qr_c, kn_c, kr_c, v_c) @ w_o
    return yx, yc


def pool_mixer(h, w_pool, scale):
    B, T, D = h.shape
    hg = h.reshape(B, T, POOL_GROUPS, POOL_GROUP)
    hf = hg.astype(jnp.float32)
    cs = jnp.concatenate([jnp.zeros((B, 1, POOL_GROUPS, POOL_GROUP), jnp.float32), jnp.cumsum(hf, axis=1)], axis=1)
    t = jnp.arange(T)[:, None]
    half = jnp.array(POOL_WINDOWS, dtype=jnp.int32)[None, :] // 2
    lo = jnp.clip(t - half, 0, T)
    hi = jnp.clip(t + half, 0, T)
    g_idx = jnp.arange(POOL_GROUPS)
    win_sum = cs[:, hi, g_idx] - cs[:, lo, g_idx]
    mean = win_sum / (hi - lo).astype(jnp.float32)[None, :, :, None]
    y = (mean - hf).astype(h.dtype)
    return jnp.einsum('btgc,gcd->btgd', y, w_pool).reshape(B, T, D) * scale


def dense_attention(q, k, v, scale):
    s = jnp.einsum('bqhd,bkhd->bhqk', q, k) * scale
    p = jax.nn.softmax(s.astype(jnp.float32), axis=-1).astype(v.dtype)
    return jnp.einsum('bhqk,bkhd->bqhd', p, v)


def na_mixer(hx, hc, ctx_out, w_qkv, g_q, g_k, rpb, w_o):
    B, S, D = hx.shape
    rows = S // GRID_W
    kr_win = min(NA_ROWS, rows)
    w = w_qkv.reshape(D, 3, NA_HEADS, NA_HEAD_DIM)
    pl = jnp.einsum('btd,dnhe->btnhe', hx, w)
    q = rms_norm(pl[:, :, 0]) * g_q
    k = rms_norm(pl[:, :, 1]) * g_k
    v = pl[:, :, 2]
    pc = jnp.einsum('btd,dnhe->btnhe', hc, w[:, 1:])
    k_c = rms_norm(pc[:, :, 0]) * g_k
    v_c = pc[:, :, 1]

    qg = q.reshape(B, rows, GRID_W, NA_HEADS, NA_HEAD_DIM)
    kg = k.reshape(B, rows, GRID_W, NA_HEADS, NA_HEAD_DIM)
    vg = v.reshape(B, rows, GRID_W, NA_HEADS, NA_HEAD_DIM)
    cols = jnp.arange(GRID_W)
    col_start = jnp.clip(cols - NA_COLS // 2, 0, GRID_W - NA_COLS)
    col_idx = col_start[:, None] + jnp.arange(NA_COLS)[None, :]
    dc_idx = col_idx - cols[:, None] + (NA_COLS - 1)
    n_loc = kr_win * NA_COLS

    def one_row(r):
        rs = jnp.clip(r - kr_win // 2, 0, rows - kr_win)
        q_r = lax.dynamic_index_in_dim(qg, r, axis=1, keepdims=False)
        k_sel = lax.dynamic_slice_in_dim(kg, rs, kr_win, axis=1)[:, :, col_idx]
        v_sel = lax.dynamic_slice_in_dim(vg, rs, kr_win, axis=1)[:, :, col_idx]
        dr_idx = rs + jnp.arange(kr_win) - r + (NA_ROWS - 1)
        bias = rpb[:, dr_idx[:, None, None], dc_idx[None, :, :]].transpose(0, 2, 1, 3)
        s_loc = jnp.einsum('bqhd,biqjhd->bhqij', q_r, k_sel) * NA_SCALE + bias
        s_ctx = jnp.einsum('bqhd,bkhd->bhqk', q_r, k_c) * NA_SCALE
        s = jnp.concatenate([s_loc.reshape(B, NA_HEADS, GRID_W, n_loc), s_ctx], axis=-1)
        p = jax.nn.softmax(s.astype(jnp.float32), axis=-1).astype(v.dtype)
        p_loc = p[..., :n_loc].reshape(B, NA_HEADS, GRID_W, kr_win, NA_COLS)
        return (jnp.einsum('bhqij,biqjhd->bqhd', p_loc, v_sel)
                + jnp.einsum('bhqk,bkhd->bqhd', p[..., n_loc:], v_c))

    o = lax.map(one_row, jnp.arange(rows))
    yx = jnp.moveaxis(o, 0, 1).reshape(B, S, D) @ w_o
    yc = None
    if ctx_out:
        q_c = rms_norm(jnp.einsum('btd,dhe->bthe', hc, w[:, 0])) * g_q
        yc = dense_attention(q_c, k_c, v_c, NA_SCALE).reshape(hc.shape) @ w_o
    return yx, yc


def conv_mixer(h, w_in, w_conv, w_out):
    b_gate, c_gate, u = jnp.split(h @ w_in, 3, axis=-1)
    z = lax.conv_general_dilated(c_gate * u, w_conv[:, None, :], window_strides=(1,),
                                 padding=((CONV_WIDTH // 2, CONV_WIDTH // 2),),
                                 dimension_numbers=('NWC', 'WIO', 'NWC'),
                                 feature_group_count=h.shape[-1])
    return (b_gate * z) @ w_out


def setup_inputs(seed: int = 0) -> dict:
    key = jax.random.key(seed)
    ks = iter(jax.random.split(key, 40))
    D = D_MODEL
    nA, nB, nC, nD = N_PER_MIXER

    def nrm(shape, scale):
        return scale * jax.random.normal(next(ks), shape, jnp.float32)

    def gain(shape):
        return 1.0 + 0.02 * jax.random.normal(next(ks), shape, jnp.float32)

    return {
        "x": nrm((BATCH, SEQ, D), 1.0),
        "c": nrm((BATCH, D), 1.0),
        "ctx": nrm((BATCH, CTX_LEN, D), 1.0),
        "c_ctx": nrm((D,), 1.0),
        "mod_w": nrm((DEPTH, D, N_MOD * D), 0.5 * D ** -0.5),
        "mod_b": nrm((DEPTH, N_MOD * D), 0.01),
        "ffn_w_in": nrm((DEPTH, 2, D, 2 * D_FF), D ** -0.5),
        "ffn_w_out": nrm((DEPTH, 2, D_FF, D), D_FF ** -0.5),
        "mla_w_dq": nrm((nA, D, MLA_Q_LORA), D ** -0.5),
        "mla_g_dq": gain((nA, MLA_Q_LORA)),
        "mla_w_uq": nrm((nA, MLA_Q_LORA, MLA_HEADS, MLA_NOPE + MLA_ROPE), MLA_Q_LORA ** -0.5),
        "mla_w_dkv": nrm((nA, D, MLA_KV_LORA + MLA_ROPE), D ** -0.5),
        "mla_g_dkv": gain((nA, MLA_KV_LORA)),
        "mla_w_uk": nrm((nA, MLA_KV_LORA, MLA_HEADS, MLA_NOPE), MLA_KV_LORA ** -0.5),
        "mla_w_uv": nrm((nA, MLA_KV_LORA, MLA_HEADS, MLA_V), MLA_KV_LORA ** -0.5),
        "mla_g_qn": gain((nA, MLA_NOPE)),
        "mla_g_qr": gain((nA, MLA_ROPE)),
        "mla_g_kn": gain((nA, MLA_NOPE)),
        "mla_g_kr": gain((nA, MLA_ROPE)),
        "mla_w_o": nrm((nA, MLA_HEADS * MLA_V, D), (MLA_HEADS * MLA_V) ** -0.5),
        "pool_w": nrm((nB, POOL_GROUPS, POOL_GROUP, POOL_GROUP), POOL_GROUP ** -0.5),
        "pool_scale": 1.0 + 0.1 * jax.random.normal(next(ks), (nB, D), jnp.float32),
        "na_w_qkv": nrm((nC, D, 3 * NA_HEADS * NA_HEAD_DIM), D ** -0.5),
        "na_g_q": gain((nC, NA_HEAD_DIM)),
        "na_g_k": gain((nC, NA_HEAD_DIM)),
        "na_rpb": nrm((nC, NA_HEADS, 2 * NA_ROWS - 1, 2 * NA_COLS - 1), 0.1),
        "na_w_o": nrm((nC, NA_HEADS * NA_HEAD_DIM, D), (NA_HEADS * NA_HEAD_DIM) ** -0.5),
        "conv_w_in": nrm((nD, D, 3 * D), D ** -0.5),
        "conv_w": nrm((nD, CONV_WIDTH, D), CONV_WIDTH ** -0.5),
        "conv_w_out": nrm((nD, D, D), D ** -0.5),
    }


def reference(x, c, ctx, c_ctx, mod_w, mod_b, ffn_w_in, ffn_w_out,
              mla_w_dq, mla_g_dq, mla_w_uq, mla_w_dkv, mla_g_dkv, mla_w_uk, mla_w_uv,
              mla_g_qn, mla_g_qr, mla_g_kn, mla_g_kr, mla_w_o,
              pool_w, pool_scale,
              na_w_qkv, na_g_q, na_g_k, na_rpb, na_w_o,
              conv_w_in, conv_w, conv_w_out):
    B, S, _ = x.shape
    ang = axial_rope_angles(S)
    h_ctx = ctx
    for i in range(DEPTH):
        kind = i % N_MIXERS
        j = i // N_MIXERS
        reads_ctx = kind in CTX_READERS
        ctx_after = any((l % N_MIXERS) in CTX_READERS for l in range(i + 1, DEPTH))
        ctx_live = reads_ctx or ctx_after
        mx = ada_params(c, mod_w[i], mod_b[i])
        x = x + 0.5 * mx[2] * swiglu(modulate(x, mx[0], mx[1]), ffn_w_in[i, 0], ffn_w_out[i, 0])
        hx = modulate(x, mx[3], mx[4])
        hc = None
        if ctx_live:
            mc = ada_params(c_ctx[None, :], mod_w[i], mod_b[i])
            h_ctx = h_ctx + 0.5 * mc[2] * swiglu(modulate(h_ctx, mc[0], mc[1]), ffn_w_in[i, 0], ffn_w_out[i, 0])
            hc = modulate(h_ctx, mc[3], mc[4])
        if kind == 0:
            yx, yc = mla_mixer(hx, hc, ang, ctx_after, mla_w_dq[j], mla_g_dq[j], mla_w_uq[j], mla_w_dkv[j],
                               mla_g_dkv[j], mla_w_uk[j], mla_w_uv[j], mla_g_qn[j], mla_g_qr[j],
                               mla_g_kn[j], mla_g_kr[j], mla_w_o[j])
        elif kind == 1:
            yx = pool_mixer(hx, pool_w[j], pool_scale[j])
            yc = pool_mixer(hc, pool_w[j], pool_scale[j]) if ctx_after else None
        elif kind == 2:
            yx, yc = na_mixer(hx, hc, ctx_after, na_w_qkv[j], na_g_q[j], na_g_k[j], na_rpb[j], na_w_o[j])
        else:
            yx = conv_mixer(hx, conv_w_in[j], conv_w[j], conv_w_out[j])
            yc = conv_mixer(hc, conv_w_in[j], conv_w[j], conv_w_out[j]) if ctx_after else None
        x = x + mx[5] * yx
        x = x + 0.5 * mx[8] * swiglu(modulate(x, mx[6], mx[7]), ffn_w_in[i, 1], ffn_w_out[i, 1])
        if ctx_after:
            h_ctx = h_ctx + mc[5] * yc
            h_ctx = h_ctx + 0.5 * mc[8] * swiglu(modulate(h_ctx, mc[6], mc[7]), ffn_w_in[i, 1], ffn_w_out[i, 1])
    return x
```

```cpp
#include <hip/hip_runtime.h>
#include <hip/hip_cooperative_groups.h>
#include <cstdio>
#include <cstdint>
namespace cg = cooperative_groups;
__device__ __forceinline__ int opaque_tid() { int t = (int)threadIdx.x; asm volatile("" : "+v"(t)); return t; }
#define LAS __attribute__((address_space(3)))
#define XB_TMO      128
#define XB_XCNT(j)  (256  + 64 * (j))
#define XB_XSUB(j)  (1280 + 64 * (j))
#define XB_XGEN(j)  (2304 + 64 * (j))
#define XB_TOP      3328
#define XB_TOPGEN   3392
#define XCD_BAR_WORDS 3456
#define XB_SPIN_CAP (1u << 18)

__device__ __forceinline__ unsigned xb_ld(unsigned* p)              { return __hip_atomic_load(p, __ATOMIC_RELAXED, __HIP_MEMORY_SCOPE_AGENT); }
__device__ __forceinline__ unsigned xb_add(unsigned* p, unsigned v) { return __hip_atomic_fetch_add(p, v, __ATOMIC_RELAXED, __HIP_MEMORY_SCOPE_AGENT); }
__device__ __forceinline__ unsigned xb_xcc_id() { return (unsigned)__builtin_amdgcn_s_getreg((3 << 11) | 20) & 0xFu; }
#define XB_SPIN(cond, bar) do { unsigned _sp = 0; while (cond) { __builtin_amdgcn_s_sleep(1); \
    if ((++_sp & 255u) == 0u) { if (xb_ld(&(bar)[XB_TMO])) break; if (_sp > XB_SPIN_CAP) { atomicAdd(&(bar)[XB_TMO], 1u); break; } } } } while (0)

struct XcdBarrier {
    unsigned* bar; unsigned x;
    volatile LAS unsigned* st;
};

__device__ __forceinline__ XcdBarrier xcd_barrier_post(unsigned* bar, volatile LAS unsigned* st) {
    XcdBarrier b; b.bar = bar; b.x = xb_xcc_id(); b.st = st;
    if (threadIdx.x == 0) (void)xb_add(&bar[XB_XCNT(b.x)], 1u);
    return b;
}
__device__ __forceinline__ void xcd_barrier_complete(unsigned* bar, unsigned x, unsigned& nloc, unsigned& nx) {
    const unsigned G = gridDim.x * gridDim.y * gridDim.z;
    unsigned sum, cnt, mine, sp = 0u;
    for (;;) {
        sum = 0u; cnt = 0u; mine = 0u;
#pragma unroll
        for (unsigned j = 0; j < 16; ++j) { const unsigned c = xb_ld(&bar[XB_XCNT(j)]); sum += c; cnt += (c > 0u) ? 1u : 0u; mine = (j == x) ? c : mine; }
        if (sum == G) break;
        __builtin_amdgcn_s_sleep(1);
        if ((++sp & 255u) == 0u) { if (xb_ld(&bar[XB_TMO])) break; if (sp > XB_SPIN_CAP) { atomicAdd(&bar[XB_TMO], 1u); break; } }
    }
    nloc = mine > 0u ? mine : 1u; nx = cnt > 0u ? cnt : 1u;
}

__device__ __forceinline__ void xcd_barrier(const XcdBarrier& b) {
    asm volatile("s_waitcnt vmcnt(0)" ::: "memory");
    __syncthreads();
    if (threadIdx.x == 0) {
        unsigned* bar = b.bar;
        __builtin_amdgcn_s_waitcnt(0);
        unsigned nloc = b.st[0], nx = b.st[1];
        if (nloc == 0u) { xcd_barrier_complete(bar, b.x, nloc, nx); b.st[0] = nloc; b.st[1] = nx; }
        const unsigned old = xb_add(&bar[XB_XSUB(b.x)], 1u);
        const unsigned gen = old / nloc;
        if (old + 1u == (gen + 1u) * nloc) {
            __builtin_amdgcn_fence(__ATOMIC_RELEASE, "agent");
            asm volatile("s_waitcnt vmcnt(0)" ::: "memory");
            const unsigned og = xb_add(&bar[XB_TOP], 1u);
            const unsigned tg = og / nx;
            if (og + 1u == (tg + 1u) * nx) xb_add(&bar[XB_TOPGEN], 1u);
            else XB_SPIN(xb_ld(&bar[XB_TOPGEN]) == tg, bar);
            __builtin_amdgcn_fence(__ATOMIC_ACQUIRE, "agent");
            xb_add(&bar[XB_XGEN(b.x)], 1u);
            asm volatile("s_waitcnt vmcnt(0)" ::: "memory");
        } else {
            XB_SPIN(xb_ld(&bar[XB_XGEN(b.x)]) == gen, bar);
            __builtin_amdgcn_fence(__ATOMIC_ACQUIRE, "agent");
            asm volatile("s_waitcnt vmcnt(0)" ::: "memory");
        }
    }
    __syncthreads();
}
namespace pg8 {
#define PG8_LAS __attribute__((address_space(3)))
typedef unsigned short bf16_t;
typedef short bf16x8 __attribute__((ext_vector_type(8)));
typedef float f32x4 __attribute__((ext_vector_type(4)));
typedef unsigned u32x4 __attribute__((ext_vector_type(4)));
constexpr int BM = 256, BK = 64, HALF = 128, HTB = HALF * BK * 2  , STAGE_BYTES = 8 * HTB, NXCD = 8, WGM = 8;

__host__ __device__ __forceinline__ int lds_byte(int r, int c) { const int st = (r >> 4) * 2 + (c >> 5), rr = r & 15, cc = c & 31, ob = rr * 64 + cc * 2; return st * 1024 + (ob ^ (((ob >> 9) & 1) << 5)); }
__host__ __device__ __forceinline__ void stage_rc(int b, int& R, int& C) { const int st = b / 1024, sb = b % 1024, swz = sb ^ (((sb >> 9) & 1) << 5); R = (st >> 1) * 16 + swz / 64; C = (st & 1) * 32 + (swz % 64) / 2; }
__host__ __device__ __forceinline__ int perm32(int rho) { const int n = rho >> 4, i = rho & 15; return 8 * (i >> 2) + 4 * n + (i & 3); }

struct Unit { int pm, pn; };
struct Gemm { const bf16_t* A; const bf16_t* Bt; int M, N, K; };

struct StaticOrder {
    int nM, nN, nwg, G, c;
    __host__ __device__ void init(int M, int N, int G_, int c_) { nM = M / BM; nN = N / BM; nwg = nM * nN; G = G_; c = c_; }
    __host__ __device__ bool next(int i, Unit& u) const {
        const long L = (long)i * G + c; if (L >= nwg) return false;
        int wgid = (int)L; { const int q = nwg / NXCD, r = nwg % NXCD, xcd = wgid % NXCD, off = wgid / NXCD; wgid = (xcd < r ? xcd * (q + 1) : r * (q + 1) + (xcd - r) * q) + off; }
        const int nig = WGM * nN, gid = wgid / nig, fm = gid * WGM, gsz = (nM - fm) < WGM ? (nM - fm) : WGM;
        u.pm = fm + ((wgid % nig) % gsz); u.pn = (wgid % nig) / gsz; return true;
    }
    __device__ __forceinline__ void a_ready(const Unit&) const {}
    __device__ __forceinline__ void done(const Unit&) const {}
};
__device__ __forceinline__ unsigned cvt_pk_bf16(float lo, float hi) { unsigned r; asm volatile("v_cvt_pk_bf16_f32 %0, %1, %2" : "=v"(r) : "v"(lo), "v"(hi)); return r; }
template <class Epi, class Sched, bool ALIGN_EPI = false, bool SP2 = false>
__device__ __forceinline__ void gemm_phase(PG8_LAS unsigned char* lds, const Gemm g, const Sched& S, const Epi& E) {
    const int tid = opaque_tid(), wid = __builtin_amdgcn_readfirstlane(tid >> 6), lane = tid & 63, wr = wid >> 2, wc = wid & 3, fr = lane & 15, fq = lane >> 4;
    const int K = g.K, nt = K / BK;
    unsigned voffA[2], voffB[2];
#pragma unroll
    for (int i = 0; i < 2; ++i) { int R, C; stage_rc(tid * 16 + i * 8192, R, C); const int Rb = Epi::PERM ? ((R & ~31) + perm32(R & 31)) : R;
        voffA[i] = (unsigned)(R * K + C) * 2u; voffB[i] = (unsigned)(Rb * K + C) * 2u; }
    const size_t kstep = (size_t)(BK * 2);
    const size_t hstep = (size_t)HALF * K * 2;
    const size_t tstep = 2 * hstep;
    const unsigned ldsw = (unsigned)wid * 1024u;
    const int aoff = lds_byte(wr * 64 + fr, fq * 8), boff = lds_byte(wc * 32 + fr, fq * 8);
#define PG8_SA(b, h) (((b) * 2 + (h)) * HTB)
#define PG8_SB(b, h) ((4 + (b) * 2 + (h)) * HTB)
#define PG8_STAGE(bufoff, gbase, voff) do { _Pragma("unroll") for (int _i = 0; _i < 2; ++_i) \
        __builtin_amdgcn_global_load_lds((const unsigned*)((const char*)(gbase) + (voff)[_i]), (PG8_LAS unsigned*)(lds + (bufoff) + ldsw + _i * 8192), 16, 0, 0); } while (0)
#define PG8_LDA(dst, b, h) do { _Pragma("unroll") for (int m = 0; m < 4; ++m) _Pragma("unroll") for (int k = 0; k < 2; ++k) dst[m][k] = *(const PG8_LAS bf16x8*)(lds + PG8_SA(b, h) + aoff + m * 2048 + k * 1024); } while (0)
#define PG8_LDB(dst, b, h) do { _Pragma("unroll") for (int n = 0; n < 2; ++n) _Pragma("unroll") for (int k = 0; k < 2; ++k) dst[n][k] = *(const PG8_LAS bf16x8*)(lds + PG8_SB(b, h) + boff + n * 2048 + k * 1024); } while (0)
#define PG8_MMA(ai, bj, At, Bt) do { __builtin_amdgcn_s_setprio(1); _Pragma("unroll") for (int m = 0; m < 4; ++m) _Pragma("unroll") for (int n = 0; n < 2; ++n) _Pragma("unroll") for (int k = 0; k < 2; ++k) \
        acc[ai][bj][m][n] = __builtin_amdgcn_mfma_f32_16x16x32_bf16(Bt[n][k], At[m][k], acc[ai][bj][m][n], 0, 0, 0); __builtin_amdgcn_s_setprio(0); } while (0)
#define PG8_WAIT_V(n) asm volatile("s_waitcnt vmcnt(" #n ")" ::: "memory")
#define PG8_WAIT_L(n) asm volatile("s_waitcnt lgkmcnt(" #n ")" ::: "memory")
#define PG8_BAR __builtin_amdgcn_s_barrier()
#define PG8_SCHED __builtin_amdgcn_sched_barrier(0)
    Unit cur, nxt; int ui = 0;
    if (!S.next(0, cur)) return;
    f32x4 acc[2][2][4][2];
#pragma unroll
    for (int a = 0; a < 2; ++a)
#pragma unroll
        for (int b = 0; b < 2; ++b)
#pragma unroll
            for (int m = 0; m < 4; ++m)
#pragma unroll
                for (int n = 0; n < 2; ++n) acc[a][b][m][n] = (f32x4){0.f, 0.f, 0.f, 0.f};
    bf16x8 At[4][2], B0[2][2], B1[2][2];
    const char* cA = (const char*)g.A + (size_t)cur.pm * tstep; const char* cB = (const char*)g.Bt + (size_t)cur.pn * tstep;
    S.a_ready(cur);
    if constexpr (SP2) {
        PG8_STAGE(PG8_SB(0, 0), cB, voffB); PG8_STAGE(PG8_SB(0, 1), cB + hstep, voffB); PG8_STAGE(PG8_SA(0, 0), cA, voffA); PG8_STAGE(PG8_SA(0, 1), cA + hstep, voffA);
        if (wr == 1) PG8_BAR;
        PG8_WAIT_V(2); PG8_BAR;
        PG8_STAGE(PG8_SB(1, 0), cB + kstep, voffB); PG8_STAGE(PG8_SA(1, 0), cA + kstep, voffA); PG8_STAGE(PG8_SB(1, 1), cB + hstep + kstep, voffB);
        PG8_WAIT_V(6); PG8_BAR;
    } else {
        PG8_STAGE(PG8_SB(0, 0), cB, voffB); PG8_STAGE(PG8_SA(0, 0), cA, voffA); PG8_STAGE(PG8_SB(0, 1), cB + hstep, voffB); PG8_STAGE(PG8_SA(0, 1), cA + hstep, voffA);
        if (wr == 1) PG8_BAR;
        PG8_WAIT_V(4); PG8_BAR;
        PG8_STAGE(PG8_SB(1, 0), cB + kstep, voffB); PG8_STAGE(PG8_SA(1, 0), cA + kstep, voffA); PG8_STAGE(PG8_SB(1, 1), cB + hstep + kstep, voffB);
        PG8_WAIT_V(6); PG8_BAR;
    }
    for (;;) {
        const bool has_next = S.next(ui + 1, nxt);
        const char* nA = has_next ? (const char*)g.A + (size_t)nxt.pm * tstep : cA; const char* nB = has_next ? (const char*)g.Bt + (size_t)nxt.pn * tstep : cB;
        for (int t = 0; t < nt; t += 2) {
            const bool last = (t == nt - 2);
            const char* a1 = cA + (size_t)(t + 1) * kstep;
            const char* a2 = last ? nA : cA + (size_t)(t + 2) * kstep; const char* b2 = last ? nB : cB + (size_t)(t + 2) * kstep;
            const char* a3 = a2 + kstep; const char* b3 = b2 + kstep;
            if (last && has_next) S.a_ready(nxt);
            if constexpr (SP2) {
            PG8_LDB(B0, 0, 0); PG8_LDB(B1, 0, 1); PG8_SCHED; PG8_LDA(At, 0, 0); PG8_STAGE(PG8_SA(1, 1), a1 + hstep, voffA);
            PG8_WAIT_V(8); PG8_WAIT_L(0); PG8_BAR; PG8_MMA(0, 0, At, B0); PG8_MMA(0, 1, At, B1); PG8_BAR; PG8_SCHED;
            PG8_LDA(At, 0, 1); PG8_STAGE(PG8_SB(0, 0), b2, voffB); PG8_STAGE(PG8_SB(0, 1), b2 + hstep, voffB); PG8_STAGE(PG8_SA(0, 0), a2, voffA);
            PG8_WAIT_V(8); PG8_WAIT_L(0); PG8_BAR; PG8_MMA(1, 0, At, B0); PG8_MMA(1, 1, At, B1); PG8_BAR; PG8_SCHED;
            PG8_LDB(B0, 1, 0); PG8_LDB(B1, 1, 1); PG8_SCHED; PG8_LDA(At, 1, 0); PG8_STAGE(PG8_SA(0, 1), a2 + hstep, voffA);
            PG8_WAIT_V(8); PG8_WAIT_L(0); PG8_BAR; PG8_MMA(0, 0, At, B0); PG8_MMA(0, 1, At, B1); PG8_BAR; PG8_SCHED;
            PG8_LDA(At, 1, 1); PG8_STAGE(PG8_SB(1, 0), b3, voffB); PG8_STAGE(PG8_SB(1, 1), b3 + hstep, voffB); PG8_STAGE(PG8_SA(1, 0), a3, voffA);
            PG8_WAIT_V(8); PG8_WAIT_L(0); PG8_BAR; PG8_MMA(1, 0, At, B0); PG8_MMA(1, 1, At, B1); PG8_BAR; PG8_SCHED;
            } else {
            PG8_LDB(B0, 0, 0); PG8_SCHED; PG8_LDA(At, 0, 0); PG8_STAGE(PG8_SA(1, 1), a1 + hstep, voffA);
            PG8_WAIT_L(8); PG8_BAR; PG8_WAIT_L(0); PG8_MMA(0, 0, At, B0); PG8_BAR; PG8_SCHED;
            PG8_LDB(B1, 0, 1); PG8_STAGE(PG8_SB(0, 0), b2, voffB);
            PG8_BAR; PG8_WAIT_L(0); PG8_MMA(0, 1, At, B1); PG8_BAR;
            PG8_LDA(At, 0, 1); PG8_STAGE(PG8_SA(0, 0), a2, voffA);
            PG8_BAR; PG8_WAIT_L(0); PG8_MMA(1, 0, At, B0); PG8_BAR; PG8_SCHED;
            PG8_STAGE(PG8_SB(0, 1), b2 + hstep, voffB);
            PG8_WAIT_V(6); PG8_BAR; PG8_MMA(1, 1, At, B1); PG8_BAR;
            PG8_LDB(B0, 1, 0); PG8_SCHED; PG8_LDA(At, 1, 0); PG8_STAGE(PG8_SA(0, 1), a2 + hstep, voffA);
            PG8_WAIT_L(8); PG8_BAR; PG8_WAIT_L(0); PG8_MMA(0, 0, At, B0); PG8_BAR; PG8_SCHED;
            PG8_LDB(B1, 1, 1); PG8_STAGE(PG8_SB(1, 0), b3, voffB);
            PG8_BAR; PG8_WAIT_L(0); PG8_MMA(0, 1, At, B1); PG8_BAR;
            PG8_LDA(At, 1, 1); PG8_STAGE(PG8_SA(1, 0), a3, voffA);
            PG8_BAR; PG8_WAIT_L(0); PG8_MMA(1, 0, At, B0); PG8_BAR; PG8_SCHED;
            PG8_STAGE(PG8_SB(1, 1), b3 + hstep, voffB);
            PG8_WAIT_V(6); PG8_BAR; PG8_MMA(1, 1, At, B1); PG8_BAR;
            }
        }
        if constexpr (ALIGN_EPI) { if (wr == 0) PG8_BAR; }
        if constexpr (!Epi::AFTER_DRAIN) { E(acc, cur, wr, wc, fr, fq); S.done(cur); }
        if (!has_next) break;
#pragma unroll
        for (int a = 0; a < 2; ++a)
#pragma unroll
            for (int b = 0; b < 2; ++b)
#pragma unroll
                for (int m = 0; m < 4; ++m)
#pragma unroll
                    for (int n = 0; n < 2; ++n) acc[a][b][m][n] = (f32x4){0.f, 0.f, 0.f, 0.f};
        cur = nxt; cA = nA; cB = nB; ++ui;
        if constexpr (ALIGN_EPI) { if (wr == 1) PG8_BAR; }
    }
    PG8_WAIT_V(0);
    if constexpr (!ALIGN_EPI) { if (wr == 0) PG8_BAR; }
    PG8_BAR;
    if constexpr (Epi::AFTER_DRAIN) { E.fused(acc, cur, wr, wc, fr, fq, lds, wid, lane); S.done(cur); }
#undef PG8_SA
#undef PG8_SB
#undef PG8_STAGE
#undef PG8_LDA
#undef PG8_LDB
#undef PG8_MMA
#undef PG8_WAIT_V
#undef PG8_WAIT_L
#undef PG8_BAR
#undef PG8_SCHED
}
}

using pg8::bf16_t; using pg8::bf16x8; using pg8::f32x4; using pg8::u32x4; using pg8::Unit;
typedef float f32x16 __attribute__((ext_vector_type(16)));
typedef unsigned u32x2 __attribute__((ext_vector_type(2)));
typedef __bf16 bf16v2 __attribute__((ext_vector_type(2)));
typedef float f32v2 __attribute__((ext_vector_type(2)));
typedef short s16x4 __attribute__((ext_vector_type(4)));

constexpr int SEQ = 16384, CTX = 256, MT = SEQ + CTX, D = 1024, DFF = 2816;
constexpr int NTHR = 512, NWAVE = 8;
constexpr int REP_NORM = 1, REP_FFNIN = 1, REP_FFNOUT = 1, REP_P0 = 1;
constexpr int LDS_BYTES = 131072 + 256;
constexpr float EPS = 1e-6f;
constexpr float LOG2E = 1.4426950408889634f;

__device__ __forceinline__ unsigned pk2(float a, float b) { f32v2 v = {a, b}; return __builtin_bit_cast(unsigned, __builtin_convertvector(v, bf16v2)); }
__device__ __forceinline__ float bf_lo(unsigned u) { return __uint_as_float(u << 16); }
__device__ __forceinline__ float bf_hi(unsigned u) { return __uint_as_float(u & 0xffff0000u); }
__device__ __forceinline__ float bf1(bf16_t h) { return __uint_as_float(((unsigned)h) << 16); }
__device__ __forceinline__ bf16_t f2bf(float f) { return (bf16_t)(pk2(f, 0.f) & 0xffffu); }
__device__ __forceinline__ float wave_sum(float v) {
#pragma unroll
    for (int o = 1; o < 64; o <<= 1) v += __shfl_xor(v, o);
    return v;
}
#define LDS_WAIT() asm volatile("s_waitcnt lgkmcnt(0)" ::: "memory")

constexpr size_t al256(size_t x) { return (x + 255) & ~(size_t)255; }
constexpr size_t WS_X = 0;
constexpr size_t WS_H = WS_X + al256((size_t)MT * D * 4);
constexpr size_t WS_BIG = WS_H + al256((size_t)MT * D * 2);
constexpr size_t WS_MIX = WS_BIG + al256((size_t)MT * 3072 * 2);
constexpr size_t WS_DQKV = WS_MIX + al256((size_t)MT * D * 2);
constexpr size_t WS_CQN = WS_DQKV + al256((size_t)MT * 768 * 2);
constexpr size_t WS_CKVN = WS_CQN + al256((size_t)MT * 384 * 2);
constexpr size_t WS_QF = WS_CKVN + al256((size_t)MT * 256 * 2);
constexpr size_t WS_KF = WS_QF + al256((size_t)8 * MT * 192 * 2);
constexpr size_t WS_VT = WS_KF + al256((size_t)8 * MT * 192 * 2);
constexpr size_t WS_MODP = WS_VT + al256((size_t)1024 * MT * 2);
constexpr size_t WS_MOD = WS_MODP + al256((size_t)4 * 32 * 2 * 9216 * 4);
constexpr size_t WS_WIN = WS_MOD + al256((size_t)4 * 2 * 9216 * 4);
constexpr size_t WS_WOUT = WS_WIN + al256((size_t)8 * 5632 * 1024 * 2);
constexpr size_t WS_MLA_DQKV = WS_WOUT + al256((size_t)8 * 1024 * 2816 * 2);
constexpr size_t WS_MLA_UQ = WS_MLA_DQKV + al256((size_t)768 * 1024 * 2);
constexpr size_t WS_MLA_UK = WS_MLA_UQ + al256((size_t)1536 * 384 * 2);
constexpr size_t WS_MLA_UVT = WS_MLA_UK + al256((size_t)1024 * 256 * 2);
constexpr size_t WS_MLA_O = WS_MLA_UVT + al256((size_t)1024 * 256 * 2);
constexpr size_t WS_POOL = WS_MLA_O + al256((size_t)1024 * 1024 * 2);
constexpr size_t WS_NA_QK = WS_POOL + al256((size_t)1024 * 1024 * 2);
constexpr size_t WS_NA_VT = WS_NA_QK + al256((size_t)2048 * 1024 * 2);
constexpr size_t WS_NA_O = WS_NA_VT + al256((size_t)1024 * 1024 * 2);
constexpr size_t WS_CV_IN = WS_NA_O + al256((size_t)1024 * 1024 * 2);
constexpr size_t WS_CV_OUT = WS_CV_IN + al256((size_t)3072 * 1024 * 2);
constexpr size_t WS_BAR = WS_CV_OUT + al256((size_t)1024 * 1024 * 2);
constexpr size_t WS_END = WS_BAR + al256((size_t)XCD_BAR_WORDS * 4);

struct EpiStore {
    static constexpr bool PERM = true, AFTER_DRAIN = false;
    bf16_t* O; int ldc; int row_base;
    __device__ __forceinline__ void operator()(const f32x4 (&acc)[2][2][4][2], const Unit& u, int wr, int wc, int fr, int fq) const {
        const int row0 = row_base + u.pm * 256 + wr * 64 + fr, col0 = u.pn * 256 + wc * 32 + 8 * fq;
#pragma unroll
        for (int ai = 0; ai < 2; ++ai)
#pragma unroll
            for (int m = 0; m < 4; ++m) { bf16_t* rowp = O + (size_t)(row0 + ai * 128 + m * 16) * ldc + col0;
#pragma unroll
                for (int bj = 0; bj < 2; ++bj) { const f32x4 v0 = acc[ai][bj][m][0], v1 = acc[ai][bj][m][1];
                    u32x4 w; w.x = pk2(v0[0], v0[1]); w.y = pk2(v0[2], v0[3]); w.z = pk2(v1[0], v1[1]); w.w = pk2(v1[2], v1[3]);
                    *(u32x4*)(rowp + bj * 128) = w; } }
    }
};
__device__ __forceinline__ float silu_f(float g) { return g * __builtin_amdgcn_rcpf(1.f + __expf(-g)); }
struct EpiSwiglu {
    static constexpr bool PERM = true, AFTER_DRAIN = false;
    bf16_t* O; int ldc; int row_base;
    __device__ __forceinline__ void operator()(const f32x4 (&acc)[2][2][4][2], const Unit& u, int wr, int wc, int fr, int fq) const {
        const int row0 = row_base + u.pm * 256 + wr * 64 + fr, col0 = u.pn * 128 + wc * 32 + 8 * fq;
#pragma unroll
        for (int ai = 0; ai < 2; ++ai)
#pragma unroll
            for (int m = 0; m < 4; ++m) { bf16_t* rowp = O + (size_t)(row0 + ai * 128 + m * 16) * ldc + col0;
                const f32x4 g0 = acc[ai][0][m][0], g1 = acc[ai][0][m][1], u0 = acc[ai][1][m][0], u1 = acc[ai][1][m][1];
                u32x4 w;
                w.x = pk2(silu_f(g0[0]) * u0[0], silu_f(g0[1]) * u0[1]); w.y = pk2(silu_f(g0[2]) * u0[2], silu_f(g0[3]) * u0[3]);
                w.z = pk2(silu_f(g1[0]) * u1[0], silu_f(g1[1]) * u1[1]); w.w = pk2(silu_f(g1[2]) * u1[2], silu_f(g1[3]) * u1[3]);
                *(u32x4*)rowp = w; }
    }
};
struct EpiResid {
    static constexpr bool PERM = true, AFTER_DRAIN = false;
    const float* xin; float* xout; const float* gate; float coef; int row_base; int out_row_off; int in_row_off;
    __device__ __forceinline__ void operator()(const f32x4 (&acc)[2][2][4][2], const Unit& u, int wr, int wc, int fr, int fq) const {
        const int row0 = row_base + u.pm * 256 + wr * 64 + fr, col0 = u.pn * 256 + wc * 32 + 8 * fq;
        f32x4 gv[2][2];
#pragma unroll
        for (int bj = 0; bj < 2; ++bj)
#pragma unroll
            for (int n = 0; n < 2; ++n) gv[bj][n] = *(const f32x4*)(gate + col0 + bj * 128 + 4 * n) * coef;
#pragma unroll
        for (int ai = 0; ai < 2; ++ai)
#pragma unroll
            for (int m = 0; m < 4; ++m) { const int row = row0 + ai * 128 + m * 16;
                const float* xi = xin + (size_t)(row - in_row_off) * D + col0; float* xo = xout + (size_t)(row - out_row_off) * D + col0;
#pragma unroll
                for (int bj = 0; bj < 2; ++bj)
#pragma unroll
                    for (int n = 0; n < 2; ++n) { const f32x4 xv = *(const f32x4*)(xi + bj * 128 + 4 * n);
                        *(f32x4*)(xo + bj * 128 + 4 * n) = xv + gv[bj][n] * acc[ai][bj][m][n]; } }
    }
};
struct EpiNaQK {
    static constexpr bool PERM = true, AFTER_DRAIN = false;
    bf16_t* QN; bf16_t* KN; const float* g_q; const float* g_k; float qscale;
    __device__ __forceinline__ void operator()(const f32x4 (&acc)[2][2][4][2], const Unit& u, int wr, int wc, int fr, int fq) const {
        const int hh = u.pn * 4 + wc; const bool isq = hh < 16; const int h = hh & 15;
        const float* g = isq ? g_q : g_k; const float sc = isq ? qscale : 1.f;
        bf16_t* outb = (isq ? QN : KN) + (size_t)h * MT * 64;
        f32x4 gv[2][2];
#pragma unroll
        for (int bj = 0; bj < 2; ++bj)
#pragma unroll
            for (int n = 0; n < 2; ++n) gv[bj][n] = *(const f32x4*)(g + 32 * bj + 8 * fq + 4 * n) * sc;
        const int row0 = u.pm * 256 + wr * 64 + fr;
#pragma unroll
        for (int ai = 0; ai < 2; ++ai)
#pragma unroll
            for (int m = 0; m < 4; ++m) { const int row = row0 + ai * 128 + m * 16;
                float ss = 0.f;
#pragma unroll
                for (int bj = 0; bj < 2; ++bj)
#pragma unroll
                    for (int n = 0; n < 2; ++n) { const f32x4 v = acc[ai][bj][m][n]; ss += (v[0] * v[0] + v[1] * v[1]) + (v[2] * v[2] + v[3] * v[3]); }
                ss += __shfl_xor(ss, 16); ss += __shfl_xor(ss, 32);
                const float rinv = rsqrtf(ss * (1.f / 64.f) + EPS);
#pragma unroll
                for (int bj = 0; bj < 2; ++bj) { const f32x4 v0 = acc[ai][bj][m][0] * gv[bj][0] * rinv, v1 = acc[ai][bj][m][1] * gv[bj][1] * rinv;
                    u32x4 w; w.x = pk2(v0[0], v0[1]); w.y = pk2(v0[2], v0[3]); w.z = pk2(v1[0], v1[1]); w.w = pk2(v1[2], v1[3]);
                    *(u32x4*)(outb + (size_t)row * 64 + 32 * bj + 8 * fq) = w; } }
    }
};
template <class Epi>
__device__ __forceinline__ void run_gemm(LAS unsigned char* lds, const bf16_t* A, const bf16_t* Bt, int M, int N, int K, const Epi& E, int rot) {
    pg8::Gemm g{A, Bt, M, N, K}; pg8::StaticOrder S; S.init(M, N, (int)gridDim.x, (int)((blockIdx.x + (unsigned)rot) % gridDim.x));
    pg8::gemm_phase<Epi, pg8::StaticOrder, true, true>(lds, g, S, E);
}

template <int K>
__device__ __forceinline__ void ctx_resid(LAS unsigned char* lds, const bf16_t* __restrict__ A, const bf16_t* __restrict__ Bt, const float* Xin, float* X,
                                          const float* __restrict__ gate, float coef) {
    const int tid = opaque_tid(), wave = tid >> 6, lane = tid & 63, fr = lane & 15, fq = lane >> 4;
    LAS float* part = (LAS float*)lds;
    constexpr int kw = K / 8;
    for (int p = blockIdx.x; p < 256; p += gridDim.x) {
        const int rb = p >> 4, cb = p & 15;
        f32x4 acc[4];
#pragma unroll
        for (int j = 0; j < 4; ++j) acc[j] = (f32x4){0.f, 0.f, 0.f, 0.f};
        const bf16_t* ap = A + (size_t)(16 * rb + fr) * K + wave * kw + 8 * fq;
        const bf16_t* bp = Bt + (size_t)(64 * cb + fr) * K + wave * kw + 8 * fq;
        const int erow = tid >> 5, ecol = (tid & 31) * 2; const size_t xo = (size_t)(16 * rb + erow) * D + 64 * cb + ecol;
        f32v2 xv = *(const f32v2*)(Xin + xo); const f32v2 gvv = *(const f32v2*)(gate + 64 * cb + ecol);
#pragma unroll
        for (int k = 0; k < kw; k += 32) {
            const bf16x8 a = *(const bf16x8*)(ap + k);
#pragma unroll
            for (int j = 0; j < 4; ++j) { const bf16x8 b = *(const bf16x8*)(bp + (size_t)(16 * j) * K + k); acc[j] = __builtin_amdgcn_mfma_f32_16x16x32_bf16(b, a, acc[j], 0, 0, 0); }
        }
#pragma unroll
        for (int j = 0; j < 4; ++j) *(LAS f32x4*)(part + (wave * 16 + fr) * 64 + 16 * j + 4 * fq) = acc[j];
        __syncthreads();
        { float s0 = 0.f, s1 = 0.f;
#pragma unroll
            for (int w = 0; w < 8; ++w) { const f32v2 v = *(const LAS f32v2*)(part + (w * 16 + erow) * 64 + ecol); s0 += v.x; s1 += v.y; }
            xv.x += coef * gvv.x * s0; xv.y += coef * gvv.y * s1; *(f32v2*)(X + xo) = xv; }
        __syncthreads();
    }
}

__device__ __forceinline__ void tr_item(const float* __restrict__ W, int ldw, int k0, int sc0, bf16_t* __restrict__ WT, int ldt, int dr0, int dc0,
                                        const float* __restrict__ scale, LAS float* scr, int lane) {
#pragma unroll 16
    for (int i = 0; i < 32; ++i) { const int kk = 2 * i + (lane >> 5); scr[kk * 33 + (lane & 31)] = W[(size_t)(k0 + kk) * ldw + sc0 + (lane & 31)]; }
    LDS_WAIT();
    const int c = lane & 7;
#pragma unroll
    for (int j = 0; j < 4; ++j) { const int n = (lane >> 3) + 8 * j; const LAS float* s = scr + (8 * c) * 33 + n;
        const float sc = scale ? scale[dr0 + n] : 1.f;
        u32x4 o; o.x = pk2(s[0 * 33] * sc, s[1 * 33] * sc); o.y = pk2(s[2 * 33] * sc, s[3 * 33] * sc); o.z = pk2(s[4 * 33] * sc, s[5 * 33] * sc); o.w = pk2(s[6 * 33] * sc, s[7 * 33] * sc);
        *(u32x4*)(WT + (size_t)(dr0 + n) * ldt + dc0 + k0 + 8 * c) = o; }
    LDS_WAIT();
}
struct ConvCtx { long base; int gw, ngw, lane; LAS float* scr; };
__device__ __forceinline__ void conv_job(ConvCtx& c, const float* W, int ldw, int K, int sc0, int ncols, bf16_t* WT, int ldt, int dr0, int dc0, const float* scale, int mode) {
    const int nblk = ncols / 32; const long n_items = (long)(K / 64) * nblk;
    long rem = ((long)c.gw - c.base) % c.ngw; if (rem < 0) rem += c.ngw;
    for (long g = c.base + rem; g < c.base + n_items; g += c.ngw) {
        const int it = (int)(g - c.base), kb = it / nblk, nb = it % nblk, n0 = 32 * nb;
        int src_col = sc0 + n0;
        if (mode == 1) { const int pn = n0 >> 8, bj = (n0 >> 7) & 1, j0 = n0 & 127; src_col = bj * DFF + 128 * pn + j0; }
        if (mode == 2) { const int pn = n0 >> 8, bj = (n0 >> 7) & 1, wcc = (n0 >> 5) & 3; src_col = sc0 + (pn * 4 + wcc) * 64 + 32 * bj; }
        tr_item(W, ldw, 64 * kb, src_col, WT, ldt, dr0 + n0, dc0, scale, c.scr, c.lane);
    }
    c.base += n_items;
}

__device__ __forceinline__ void norm_phase(const float* __restrict__ Xc, const float* __restrict__ Xl, bf16_t* __restrict__ H, const float* __restrict__ modL, int i_shift, int i_scale, int row_begin) {
    const int tid_ = opaque_tid(), lane = tid_ & 63, gw = blockIdx.x * NWAVE + (tid_ >> 6), ngw = gridDim.x * NWAVE;
    for (int row = row_begin + gw; row < MT; row += ngw) {
        const float* mp = modL + (row >= CTX ? 9216 : 0);
        const f32x4* xr = (const f32x4*)(row >= CTX ? Xl + (size_t)(row - CTX) * D : Xc + (size_t)row * D) + lane;
        f32x4 v[4]; float ss = 0.f;
#pragma unroll
        for (int j = 0; j < 4; ++j) { v[j] = xr[64 * j]; ss += (v[j].x * v[j].x + v[j].y * v[j].y) + (v[j].z * v[j].z + v[j].w * v[j].w); }
        const float rinv = rsqrtf(wave_sum(ss) * (1.f / D) + EPS);
        u32x2* o = (u32x2*)(H + (size_t)row * D) + lane;
#pragma unroll
        for (int j = 0; j < 4; ++j) {
            const f32x4 sh = *((const f32x4*)(mp + i_shift * D) + lane + 64 * j), sc = *((const f32x4*)(mp + i_scale * D) + lane + 64 * j);
            const f32x4 h = v[j] * rinv * (sc + 1.f) + sh;
            u32x2 w; w.x = pk2(h.x, h.y); w.y = pk2(h.z, h.w); o[64 * j] = w; }
    }
}

__device__ __forceinline__ float rope_elem(float val, float oth, int e, int t) {
    if (t < 0) return val;
    const int p = e >> 1, fi = p & 15;
    const float freq = __builtin_amdgcn_exp2f(-(float)fi * (13.287712379549449f / 16.f));
    const float pos = (p < 16) ? (float)(t >> 6) : (float)(t & 63);
    const float rev = pos * freq * 0.15915494309189535f, fr_ = rev - floorf(rev);
    const float sn = __builtin_amdgcn_sinf(fr_), cs = __builtin_amdgcn_cosf(fr_);
    return (e & 1) ? (oth * sn + val * cs) : (val * cs - oth * sn);
}

__device__ __forceinline__ void mla_na_phase(const bf16_t* __restrict__ R, bf16_t* __restrict__ CQN, bf16_t* __restrict__ CKVN, bf16_t* __restrict__ KF,
                                             const float* __restrict__ g_dq, const float* __restrict__ g_dkv, const float* __restrict__ g_kr) {
    const int tid_ = opaque_tid(), lane = tid_ & 63, gw = blockIdx.x * NWAVE + (tid_ >> 6), ngw = gridDim.x * NWAVE;
    for (int rowa = gw; rowa < MT; rowa += 2 * ngw) {
        int rows[2] = {rowa, min(rowa + ngw, MT - 1)};
        unsigned q[2][3]; u32x2 kv[2]; float kr[2], ss[2], sk[2], sr[2];
#pragma unroll
        for (int u = 0; u < 2; ++u) { const bf16_t* r = R + (size_t)rows[u] * 768;
#pragma unroll
            for (int j = 0; j < 3; ++j) q[u][j] = *((const unsigned*)r + lane + 64 * j);
            kv[u] = *((const u32x2*)(r + 384) + lane); kr[u] = bf1(r[640 + lane]); }
#pragma unroll
        for (int u = 0; u < 2; ++u) { float s_ = 0.f;
#pragma unroll
            for (int j = 0; j < 3; ++j) { const float a = bf_lo(q[u][j]), b = bf_hi(q[u][j]); s_ += a * a + b * b; }
            ss[u] = s_;
            const float k0 = bf_lo(kv[u].x), k1 = bf_hi(kv[u].x), k2 = bf_lo(kv[u].y), k3 = bf_hi(kv[u].y);
            sk[u] = k0 * k0 + k1 * k1 + k2 * k2 + k3 * k3; sr[u] = kr[u] * kr[u]; }
#pragma unroll
        for (int o = 1; o < 64; o <<= 1)
#pragma unroll
            for (int u = 0; u < 2; ++u) { ss[u] += __shfl_xor(ss[u], o); sk[u] += __shfl_xor(sk[u], o); sr[u] += __shfl_xor(sr[u], o); }
#pragma unroll
        for (int u = 0; u < 2; ++u) { const int row = rows[u];
            const float rq = rsqrtf(ss[u] * (1.f / 384.f) + EPS), rk = rsqrtf(sk[u] * (1.f / 256.f) + EPS), rr = rsqrtf(sr[u] * (1.f / 64.f) + EPS);
#pragma unroll
            for (int j = 0; j < 3; ++j) { const int e = 2 * lane + 128 * j;
                *((unsigned*)(CQN + (size_t)row * 384) + lane + 64 * j) = pk2(bf_lo(q[u][j]) * rq * g_dq[e], bf_hi(q[u][j]) * rq * g_dq[e + 1]); }
            const float k0 = bf_lo(kv[u].x), k1 = bf_hi(kv[u].x), k2 = bf_lo(kv[u].y), k3 = bf_hi(kv[u].y);
            u32x2 w; w.x = pk2(k0 * rk * g_dkv[4 * lane], k1 * rk * g_dkv[4 * lane + 1]); w.y = pk2(k2 * rk * g_dkv[4 * lane + 2], k3 * rk * g_dkv[4 * lane + 3]);
            *((u32x2*)(CKVN + (size_t)row * 256) + lane) = w;
            const float val = kr[u] * rr * g_kr[lane], oth = __shfl_xor(val, 1);
            const bf16_t ko = f2bf(rope_elem(val, oth, lane, row - CTX));
#pragma unroll
            for (int h = 0; h < 8; ++h) KF[((size_t)h * MT + row) * 192 + 128 + lane] = ko; }
    }
}
__device__ __forceinline__ void mla_nb_phase(const bf16_t* __restrict__ QR, const bf16_t* __restrict__ KR, bf16_t* __restrict__ QF, bf16_t* __restrict__ KF,
                                             const float* __restrict__ g_qn, const float* __restrict__ g_qr, const float* __restrict__ g_kn, float qscale) {
    const int tid_ = opaque_tid(), lane = tid_ & 63, gw = blockIdx.x * NWAVE + (tid_ >> 6), ngw = gridDim.x * NWAVE;
    const float gq0 = g_qn[2 * lane], gq1 = g_qn[2 * lane + 1], gk0 = g_kn[2 * lane], gk1 = g_kn[2 * lane + 1], gr = g_qr[lane];
    for (int row = gw; row < MT; row += ngw) {
#pragma unroll 4
        for (int h = 0; h < 8; ++h) {
            const bf16_t* q = QR + (size_t)row * 1536 + h * 192;
            const unsigned qn = *((const unsigned*)q + lane); const float qrv = bf1(q[128 + lane]);
            const unsigned kn = *((const unsigned*)(KR + (size_t)row * 1024 + h * 128) + lane);
            const float a = bf_lo(qn), b = bf_hi(qn), c = bf_lo(kn), d = bf_hi(kn);
            const float r1 = rsqrtf(wave_sum(a * a + b * b) * (1.f / 128.f) + EPS);
            const float r2 = rsqrtf(wave_sum(qrv * qrv) * (1.f / 64.f) + EPS);
            const float r3 = rsqrtf(wave_sum(c * c + d * d) * (1.f / 128.f) + EPS);
            bf16_t* qo = QF + ((size_t)h * MT + row) * 192;
            *((unsigned*)qo + lane) = pk2(a * r1 * gq0 * qscale, b * r1 * gq1 * qscale);
            const float val = qrv * r2 * gr, oth = __shfl_xor(val, 1);
            qo[128 + lane] = f2bf(rope_elem(val, oth, lane, row - CTX) * qscale);
            *((unsigned*)(KF + ((size_t)h * MT + row) * 192) + lane) = pk2(c * r3 * gk0, d * r3 * gk1);
        }
    }
}
__device__ __forceinline__ void na_norm_phase(const bf16_t* __restrict__ R, bf16_t* __restrict__ QN, bf16_t* __restrict__ KN,
                                              const float* __restrict__ g_q, const float* __restrict__ g_k, float qscale) {
    const int tid_ = opaque_tid(), lane = tid_ & 63, gw = blockIdx.x * NWAVE + (tid_ >> 6), ngw = gridDim.x * NWAVE;
    const int e0 = 8 * (lane & 7);
    for (int row = gw; row < MT; row += ngw) {
#pragma unroll
        for (int j = 0; j < 4; ++j) {
            const u32x4 v = *((const u32x4*)(R + (size_t)row * 2048 + j * 512) + lane);
            float f[8] = {bf_lo(v.x), bf_hi(v.x), bf_lo(v.y), bf_hi(v.y), bf_lo(v.z), bf_hi(v.z), bf_lo(v.w), bf_hi(v.w)};
            float ss = 0.f;
#pragma unroll
            for (int i = 0; i < 8; ++i) ss += f[i] * f[i];
            ss += __shfl_xor(ss, 1); ss += __shfl_xor(ss, 2); ss += __shfl_xor(ss, 4);
            const float rinv = rsqrtf(ss * (1.f / 64.f) + EPS);
            const int seg = j * 8 + (lane >> 3);
            const bool isq = seg < 16; const int h = seg & 15;
            const float* g = isq ? g_q : g_k; const float sc = isq ? rinv * qscale : rinv;
            u32x4 w; w.x = pk2(f[0] * sc * g[e0], f[1] * sc * g[e0 + 1]); w.y = pk2(f[2] * sc * g[e0 + 2], f[3] * sc * g[e0 + 3]);
            w.z = pk2(f[4] * sc * g[e0 + 4], f[5] * sc * g[e0 + 5]); w.w = pk2(f[6] * sc * g[e0 + 6], f[7] * sc * g[e0 + 7]);
            *(u32x4*)((isq ? QN : KN) + ((size_t)h * MT + row) * 64 + e0) = w;
        }
    }
}
template <int G>
__device__ __forceinline__ void pool_group(const bf16_t* __restrict__ H, bf16_t* __restrict__ Y) {
    constexpr int HALF = 1 << G, W = 2 * HALF;
    const long n = (long)MT * 32, stride = (long)gridDim.x * NTHR;
    for (long idx = (long)blockIdx.x * NTHR + opaque_tid(); idx < n; idx += stride) {
        const int row = (int)(idx >> 5), ch = G * 32 + (int)(idx & 31);
        const int base = row >= CTX ? CTX : 0, T = row >= CTX ? SEQ : CTX, ts = row - base;
        const int lo = max(ts - HALF, 0), hi = min(ts + HALF, T);
        u32x4 v[W];
#pragma unroll
        for (int j = 0; j < W; ++j) { const int r = min(max(ts - HALF + j, 0), T - 1); v[j] = *((const u32x4*)(H + (size_t)(base + r) * D) + ch); }
        const u32x4 c = *((const u32x4*)(H + (size_t)row * D) + ch);
        float s[8] = {0, 0, 0, 0, 0, 0, 0, 0};
#pragma unroll
        for (int j = 0; j < W; ++j) { const int r = ts - HALF + j; const float wgt = (r >= lo && r < hi) ? 1.f : 0.f;
            s[0] += wgt * bf_lo(v[j].x); s[1] += wgt * bf_hi(v[j].x); s[2] += wgt * bf_lo(v[j].y); s[3] += wgt * bf_hi(v[j].y);
            s[4] += wgt * bf_lo(v[j].z); s[5] += wgt * bf_hi(v[j].z); s[6] += wgt * bf_lo(v[j].w); s[7] += wgt * bf_hi(v[j].w); }
        const float inv = 1.f / (float)(hi - lo);
        u32x4 w; w.x = pk2(s[0] * inv - bf_lo(c.x), s[1] * inv - bf_hi(c.x)); w.y = pk2(s[2] * inv - bf_lo(c.y), s[3] * inv - bf_hi(c.y));
        w.z = pk2(s[4] * inv - bf_lo(c.z), s[5] * inv - bf_hi(c.z)); w.w = pk2(s[6] * inv - bf_lo(c.w), s[7] * inv - bf_hi(c.w));
        *((u32x4*)(Y + (size_t)row * D) + ch) = w;
    }
}
__device__ __forceinline__ void pool_phase(const bf16_t* __restrict__ H, bf16_t* __restrict__ Y) {
    pool_group<0>(H, Y); pool_group<1>(H, Y); pool_group<2>(H, Y); pool_group<3>(H, Y);
}
__device__ __forceinline__ void conv_phase(const bf16_t* __restrict__ R, bf16_t* __restrict__ G, const float* __restrict__ cw) {
    const long n = (long)MT * 128, stride = (long)gridDim.x * NTHR;
    for (long idx = (long)CTX * 128 + (long)blockIdx.x * NTHR + opaque_tid(); idx < n; idx += stride) {
        const int row = (int)(idx >> 7), ch = (int)(idx & 127);
        const int lo = row >= CTX ? CTX : 0, hi = row >= CTX ? MT : CTX;
        float z[8] = {0, 0, 0, 0, 0, 0, 0, 0};
#pragma unroll
        for (int k = 0; k < 3; ++k) { const int r = row + k - 1;
            if (r >= lo && r < hi) {
                const u32x4 c = *((const u32x4*)(R + (size_t)r * 3072 + 1024) + ch), u = *((const u32x4*)(R + (size_t)r * 3072 + 2048) + ch);
                const f32x4 w0 = *((const f32x4*)(cw + k * D) + 2 * ch), w1 = *((const f32x4*)(cw + k * D) + 2 * ch + 1);
                z[0] += w0.x * bf_lo(c.x) * bf_lo(u.x); z[1] += w0.y * bf_hi(c.x) * bf_hi(u.x); z[2] += w0.z * bf_lo(c.y) * bf_lo(u.y); z[3] += w0.w * bf_hi(c.y) * bf_hi(u.y);
                z[4] += w1.x * bf_lo(c.z) * bf_lo(u.z); z[5] += w1.y * bf_hi(c.z) * bf_hi(u.z); z[6] += w1.z * bf_lo(c.w) * bf_lo(u.w); z[7] += w1.w * bf_hi(c.w) * bf_hi(u.w); } }
        const u32x4 b = *((const u32x4*)(R + (size_t)row * 3072) + ch);
        u32x4 w; w.x = pk2(z[0] * bf_lo(b.x), z[1] * bf_hi(b.x)); w.y = pk2(z[2] * bf_lo(b.y), z[3] * bf_hi(b.y));
        w.z = pk2(z[4] * bf_lo(b.z), z[5] * bf_hi(b.z)); w.w = pk2(z[6] * bf_lo(b.w), z[7] * bf_hi(b.w));
        *((u32x4*)(G + (size_t)row * D) + ch) = w;
    }
}

template <int DQK, int DV, bool NA>
__device__ __forceinline__ void attn_phase(LAS unsigned char* lds, const bf16_t* __restrict__ Q, const bf16_t* __restrict__ Kf, const bf16_t* __restrict__ VT,
                                           bf16_t* __restrict__ O, const float* __restrict__ rpb, int H, bool with_ctx) {
    constexpr int KSTR = (DQK + 8) * 2, VSTR = (64 + 8) * 2, KBUF = 64 * KSTR, VBUF = DV * VSTR;
    constexpr int KCH = DQK / 8, NKL = 64 * KCH / NTHR, NVL = DV * 8 / NTHR, NKS = DQK / 16, NDV = DV / 32;
    constexpr int RPB_OFF = 2 * KBUF + 2 * VBUF;
    const int tid = opaque_tid(), wave = tid >> 6, lane = tid & 63, r = lane & 31, hh = lane >> 5;
    LAS float* rpbL = (LAS float*)(lds + RPB_OFF);
    const int nbig = 64 * H, nunits = with_ctx ? 65 * H : 64 * H;
    for (int u = blockIdx.x; u < nunits; u += gridDim.x) {
        int head, qb;
        if (u < nbig) { const int b = u & 255, rnd = u >> 8, xcd = b & 7, slot = b >> 3; head = xcd + 8 * (rnd >> 1); qb = 1 + (rnd & 1) * 32 + slot; }
        else { head = u - nbig; qb = 0; }
        int nloc = 0, rlo = 0, NT;
        if (!NA) NT = (qb == 0) ? 4 : 260;
        else { if (qb > 0) { const int r0 = 4 * (qb - 1); rlo = min(max(r0 - 4, 0), 248); const int rhi = min(max(r0 - 1, 0), 248) + 7; nloc = rhi - rlo + 1; } NT = nloc + 4; }
#define TILE_ROW0(t) (!NA ? 64 * (t) : ((t) < nloc ? CTX + 64 * (rlo + (t)) : 64 * ((t) - nloc)))
        const int qrow = 256 * qb + 32 * wave + r;
        const int rq = 4 * (qb - 1) + (wave >> 1), cq = 32 * (wave & 1) + r;
        const int rs = min(max(rq - 4, 0), 248), cs = min(max(cq - 8, 0), 48);
        bf16x8 qf[NKS];
#pragma unroll
        for (int ks = 0; ks < NKS; ++ks) qf[ks] = *(const bf16x8*)(Q + ((size_t)head * MT + qrow) * DQK + 16 * ks + 8 * hh);
        u32x4 kreg[NKL], vreg[NVL];
#define ATT_LOAD(t) do { const int row0_ = TILE_ROW0(t); \
        _Pragma("unroll") for (int i = 0; i < NKL; ++i) { const int c_ = tid + NTHR * i, kr_ = c_ / KCH, kc_ = c_ % KCH; kreg[i] = *(const u32x4*)(Kf + ((size_t)head * MT + row0_ + kr_) * DQK + kc_ * 8); } \
        _Pragma("unroll") for (int i = 0; i < NVL; ++i) { const int c_ = tid + NTHR * i, vr_ = c_ >> 3, vc_ = c_ & 7; vreg[i] = *(const u32x4*)(VT + (size_t)(head * DV + vr_) * MT + row0_ + vc_ * 8); } } while (0)
#define ATT_STORE(buf) do { \
        _Pragma("unroll") for (int i = 0; i < NKL; ++i) { const int c_ = tid + NTHR * i, kr_ = c_ / KCH, kc_ = c_ % KCH; *(LAS u32x4*)(lds + (buf) * KBUF + kr_ * KSTR + kc_ * 16) = kreg[i]; } \
        _Pragma("unroll") for (int i = 0; i < NVL; ++i) { const int c_ = tid + NTHR * i, vr_ = c_ >> 3, vc_ = c_ & 7; *(LAS u32x4*)(lds + 2 * KBUF + (buf) * VBUF + vr_ * VSTR + vc_ * 16) = vreg[i]; } } while (0)
        ATT_LOAD(0); ATT_STORE(0);
        if (NA) { for (int i = tid; i < 15 * 31; i += NTHR) rpbL[i] = rpb[head * (15 * 31) + i] * LOG2E; }
        __syncthreads();
        float mrun = -INFINITY, lsum = 0.f;
        f32x16 o[NDV];
#pragma unroll
        for (int d = 0; d < NDV; ++d)
#pragma unroll
            for (int i = 0; i < 16; ++i) o[d][i] = 0.f;
        for (int t = 0; t < NT; ++t) {
            const int cur = t & 1;
            if (t + 1 < NT) ATT_LOAD(t + 1);
            bool active = true; int rr = 0; const bool local = NA && (t < nloc);
            if (local) { rr = rlo + t; active = (rr >= rs) && (rr < rs + 8); }
            if (active) {
                f32x16 s[2];
#pragma unroll
                for (int kb = 0; kb < 2; ++kb) {
#pragma unroll
                    for (int i = 0; i < 16; ++i) s[kb][i] = 0.f;
#pragma unroll
                    for (int ks = 0; ks < NKS; ++ks) {
                        const bf16x8 a = *(const LAS bf16x8*)(lds + cur * KBUF + (32 * kb + r) * KSTR + (16 * ks + 8 * hh) * 2);
                        s[kb] = __builtin_amdgcn_mfma_f32_32x32x16_bf16(a, qf[ks], s[kb], 0, 0, 0);
                    }
                }
                if (local) {
                    const int dr = rr - rq + 7;
#pragma unroll
                    for (int kb = 0; kb < 2; ++kb)
#pragma unroll
                        for (int i = 0; i < 16; ++i) { const int kc = 32 * kb + (i & 3) + 8 * (i >> 2) + 4 * hh; const bool valid = (kc >= cs) && (kc < cs + 16);
                            const int dc = min(max(kc - cq + 15, 0), 30);
                            const float bias = rpbL[dr * 31 + dc];
                            s[kb][i] = valid ? s[kb][i] + bias : -INFINITY; }
                }
                float mx = s[0][0];
#pragma unroll
                for (int i = 1; i < 16; ++i) mx = fmaxf(mx, s[0][i]);
#pragma unroll
                for (int i = 0; i < 16; ++i) mx = fmaxf(mx, s[1][i]);
                mx = fmaxf(mx, __shfl_xor(mx, 32));
                const float mnew = fmaxf(mrun, mx), alpha = __builtin_amdgcn_exp2f(mrun - mnew);
                mrun = mnew;
                float ps = 0.f;
#pragma unroll
                for (int kb = 0; kb < 2; ++kb)
#pragma unroll
                    for (int i = 0; i < 16; ++i) { s[kb][i] = __builtin_amdgcn_exp2f(s[kb][i] - mnew); ps += s[kb][i]; }
                lsum = lsum * alpha + ps;
#pragma unroll
                for (int d = 0; d < NDV; ++d)
#pragma unroll
                    for (int i = 0; i < 16; ++i) o[d][i] *= alpha;
#pragma unroll
                for (int kb = 0; kb < 2; ++kb)
#pragma unroll
                    for (int sx = 0; sx < 2; ++sx) {
                        u32x4 pw; pw.x = pk2(s[kb][8 * sx + 0], s[kb][8 * sx + 1]); pw.y = pk2(s[kb][8 * sx + 2], s[kb][8 * sx + 3]);
                        pw.z = pk2(s[kb][8 * sx + 4], s[kb][8 * sx + 5]); pw.w = pk2(s[kb][8 * sx + 6], s[kb][8 * sx + 7]);
                        const bf16x8 pb = __builtin_bit_cast(bf16x8, pw);
#pragma unroll
                        for (int d = 0; d < NDV; ++d) {
                            const LAS unsigned char* vp = lds + 2 * KBUF + cur * VBUF + (32 * d + r) * VSTR + (32 * kb + 16 * sx + 4 * hh) * 2;
                            const u32x2 v0 = *(const LAS u32x2*)vp, v1 = *(const LAS u32x2*)(vp + 16);
                            u32x4 vw; vw.x = v0.x; vw.y = v0.y; vw.z = v1.x; vw.w = v1.y;
                            o[d] = __builtin_amdgcn_mfma_f32_32x32x16_bf16(__builtin_bit_cast(bf16x8, vw), pb, o[d], 0, 0, 0);
                        }
                    }
            }
            if (t + 1 < NT) ATT_STORE(cur ^ 1);
            __syncthreads();
        }
        const float ltot = lsum + __shfl_xor(lsum, 32), inv = 1.f / ltot;
        bf16_t* orow = O + (size_t)qrow * (H * DV) + head * DV;
#pragma unroll
        for (int d = 0; d < NDV; ++d)
#pragma unroll
            for (int g = 0; g < 4; ++g) { u32x2 w; w.x = pk2(o[d][4 * g] * inv, o[d][4 * g + 1] * inv); w.y = pk2(o[d][4 * g + 2] * inv, o[d][4 * g + 3] * inv);
                *(u32x2*)(orow + 32 * d + 8 * g + 4 * hh) = w; }
#undef ATT_LOAD
#undef ATT_STORE
#undef TILE_ROW0
    }
}

__device__ __forceinline__ int swap23(int r) { return (r & ~12) | ((r & 4) << 1) | ((r & 8) >> 1); }
struct MlaOff { int ko1[8], ko2[4], vo[4]; };
constexpr int MLA_K1 = 0, MLA_K2 = 49152, MLA_V = 73728;
template <int SLOT, int KB> __device__ __forceinline__ void mla_s1(f32x16& sd, const f32x16& cinit, LAS unsigned char* lds, const MlaOff& F, const bf16x8 (&qf)[12]) {
    { const bf16x8 a = *(const LAS bf16x8*)(lds + F.ko1[0] + (SLOT * 16384 + KB * 8192)); sd = __builtin_amdgcn_mfma_f32_32x32x16_bf16(a, qf[0], cinit, 0, 0, 0); }
#pragma unroll
    for (int ks = 1; ks < 8; ++ks) { const bf16x8 a = *(const LAS bf16x8*)(lds + F.ko1[ks] + (SLOT * 16384 + KB * 8192)); sd = __builtin_amdgcn_mfma_f32_32x32x16_bf16(a, qf[ks], sd, 0, 0, 0); }
#pragma unroll
    for (int ks = 0; ks < 4; ++ks) { const bf16x8 a = *(const LAS bf16x8*)(lds + F.ko2[ks] + (SLOT * 8192 + KB * 4096)); sd = __builtin_amdgcn_mfma_f32_32x32x16_bf16(a, qf[8 + ks], sd, 0, 0, 0); }
}
template <int VS, int KB, int NS, int NKB>
__device__ __forceinline__ void mla_step(f32x16& sc, f32x16& sn, f32x16 (&o)[4], f32x16& negm, float& lsum, float& mxc, LAS unsigned char* lds, const MlaOff& F, const bf16x8 (&qf)[12]) {
    if (__any(mxc > 0.f)) { const float dlt = fmaxf(mxc, 0.f), alpha = __builtin_amdgcn_exp2f(-dlt); lsum *= alpha;
#pragma unroll
        for (int i = 0; i < 16; ++i) { negm[i] -= dlt; sc[i] -= dlt; }
#pragma unroll
        for (int d = 0; d < 4; ++d)
#pragma unroll
            for (int i = 0; i < 16; ++i) o[d][i] *= alpha; }
    mla_s1<NS, NKB>(sn, negm, lds, F, qf);
    float ps = 0.f;
#pragma unroll
    for (int i = 0; i < 16; ++i) { sc[i] = __builtin_amdgcn_exp2f(sc[i]); ps += sc[i]; }
    lsum += ps;
#pragma unroll
    for (int sx = 0; sx < 2; ++sx) {
        u32x4 pw; pw.x = pk2(sc[8 * sx + 0], sc[8 * sx + 1]); pw.y = pk2(sc[8 * sx + 2], sc[8 * sx + 3]); pw.z = pk2(sc[8 * sx + 4], sc[8 * sx + 5]); pw.w = pk2(sc[8 * sx + 6], sc[8 * sx + 7]);
        const bf16x8 pb = __builtin_bit_cast(bf16x8, pw);
#pragma unroll
        for (int d = 0; d < 4; ++d) { const bf16x8 va = *(const LAS bf16x8*)(lds + F.vo[2 * KB + sx] + (VS * 16384 + d * 4096)); o[d] = __builtin_amdgcn_mfma_f32_32x32x16_bf16(va, pb, o[d], 0, 0, 0); } }
    float mx = sn[0];
#pragma unroll
    for (int i = 1; i < 16; ++i) mx = fmaxf(mx, sn[i]);
    mxc = fmaxf(mx, __shfl_xor(mx, 32));
}
__device__ __forceinline__ void attn_mla_phase(LAS unsigned char* lds, const bf16_t* __restrict__ Q, const bf16_t* __restrict__ Kf, const bf16_t* __restrict__ VT, bf16_t* __restrict__ O) {
    constexpr int H = 8, DQK = 192, DV = 128;
    const int tid = opaque_tid(), wave = __builtin_amdgcn_readfirstlane(tid >> 6), lane = tid & 63, r = lane & 31, hh = lane >> 5;
    unsigned goff[5], lbase[5], lstr[5]; bool isv[5];
#pragma unroll
    for (int i = 0; i < 5; ++i) {
        const int j = wave * 5 + i;
        if (j < 16) { const int q = j * 64 + lane, key = q >> 4, c = (q & 15) ^ (key & 15); goff[i] = key * DQK + c * 8; lbase[i] = MLA_K1 + j * 1024; lstr[i] = 16384; isv[i] = false; }
        else if (j < 24) { const int q = (j - 16) * 64 + lane, row = q >> 4, cc = (q & 15) ^ (row & 15), key = 2 * row + (cc >> 3); goff[i] = key * DQK + 128 + (cc & 7) * 8; lbase[i] = MLA_K2 + (j - 16) * 1024; lstr[i] = 8192; isv[i] = false; }
        else { const int q = (j - 24) * 64 + lane, row2 = q >> 4, cc = (q & 15) ^ (row2 & 15), dv = 2 * row2 + (cc >> 3); goff[i] = dv * MT + (cc & 7) * 8; lbase[i] = MLA_V + (j - 24) * 1024; lstr[i] = 16384; isv[i] = true; }
    }
    MlaOff F;
    { const int pr = swap23(r), kx = pr & 15, k1row = pr * 256, k2row = (pr >> 1) * 256, k2cb = (pr & 1) * 8, k2x = (pr >> 1) & 15, vrow = (r >> 1) * 256, vcb = (r & 1) * 8, vx = (r >> 1) & 15;
#pragma unroll
      for (int ks = 0; ks < 8; ++ks) F.ko1[ks] = MLA_K1 + k1row + (((2 * ks + hh) ^ kx) << 4);
#pragma unroll
      for (int ks = 0; ks < 4; ++ks) F.ko2[ks] = MLA_K2 + k2row + (((k2cb + 2 * ks + hh) ^ k2x) << 4);
#pragma unroll
      for (int c = 0; c < 4; ++c) F.vo[c] = MLA_V + vrow + (((vcb + 2 * c + hh) ^ vx) << 4); }
    const int nbig = 64 * H, nunits = 65 * H;
    for (int u = blockIdx.x; u < nunits; u += gridDim.x) {
        int head, qb;
        if (u < nbig) { const int b = u & 255, rnd = u >> 8, xcd = b & 7, slot = b >> 3; head = xcd + 8 * (rnd >> 1); qb = 1 + (rnd & 1) * 32 + slot; }
        else { head = u - nbig; qb = 0; }
        const int NT = (qb == 0) ? 4 : 260;
        const int qrow = 256 * qb + 32 * wave + r;
        bf16x8 qf[12];
#pragma unroll
        for (int ks = 0; ks < 12; ++ks) qf[ks] = *(const bf16x8*)(Q + ((size_t)head * MT + qrow) * DQK + 16 * ks + 8 * hh);
        const bf16_t* kbase = Kf + (size_t)head * MT * DQK; const bf16_t* vbase = VT + (size_t)head * DV * MT;
#define MLA_ISSUE(s, SL) do { const bf16_t* kb_ = kbase + (size_t)(s) * 64 * DQK; const bf16_t* vb_ = vbase + (size_t)(s) * 64; \
        _Pragma("unroll") for (int i = 0; i < 5; ++i) __builtin_amdgcn_global_load_lds((const unsigned*)((isv[i] ? vb_ : kb_) + goff[i]), (LAS unsigned*)(lds + lbase[i] + (SL) * lstr[i]), 16, 0, 0); } while (0)
#define MLA_WAITBAR() do { asm volatile("s_waitcnt vmcnt(0)" ::: "memory"); __builtin_amdgcn_s_barrier(); asm volatile("" ::: "memory"); } while (0)
#define MLA_TILE(t, SL) do { \
        mla_step<SL, 0, SL, 1>(sA, sB, o, negm, lsum, mxc, lds, F, qf); \
        if ((t) + 2 < NT) MLA_ISSUE((t) + 2, ((SL) + 2) % 3); \
        mla_step<SL, 1, ((SL) + 1) % 3, 0>(sB, sA, o, negm, lsum, mxc, lds, F, qf); \
        MLA_WAITBAR(); } while (0)
        float lsum = 0.f, mxc;
        f32x16 o[4], sA, sB, negm;
#pragma unroll
        for (int d = 0; d < 4; ++d)
#pragma unroll
            for (int i = 0; i < 16; ++i) o[d][i] = 0.f;
        MLA_ISSUE(0, 0); MLA_ISSUE(1, 1);
        MLA_WAITBAR();
        { f32x16 z;
#pragma unroll
          for (int i = 0; i < 16; ++i) z[i] = 0.f;
          mla_s1<0, 0>(sA, z, lds, F, qf);
          float mx_ = sA[0];
#pragma unroll
          for (int i = 1; i < 16; ++i) mx_ = fmaxf(mx_, sA[i]);
          mx_ = fmaxf(mx_, __shfl_xor(mx_, 32));
#pragma unroll
          for (int i = 0; i < 16; ++i) { negm[i] = -mx_; sA[i] -= mx_; }
          mxc = 0.f; }
        int t = 0;
        for (; t + 3 <= NT; t += 3) { MLA_TILE(t, 0); MLA_TILE(t + 1, 1); MLA_TILE(t + 2, 2); }
        if (t < NT) { MLA_TILE(t, 0); if (t + 1 < NT) MLA_TILE(t + 1, 1); }
        const float ltot = lsum + __shfl_xor(lsum, 32), inv = 1.f / ltot;
        bf16_t* orow = O + (size_t)qrow * (H * DV) + head * DV;
#pragma unroll
        for (int d = 0; d < 4; ++d)
#pragma unroll
            for (int g = 0; g < 4; ++g) { u32x2 w; w.x = pk2(o[d][4 * g] * inv, o[d][4 * g + 1] * inv); w.y = pk2(o[d][4 * g + 2] * inv, o[d][4 * g + 3] * inv);
                *(u32x2*)(orow + 32 * d + 8 * g + 4 * hh) = w; }
#undef MLA_ISSUE
#undef MLA_WAITBAR
#undef MLA_TILE
    }
}

struct Args { const float* in[30]; float* out; unsigned char* ws; int ph_lo, ph_hi; };

typedef const __attribute__((address_space(4))) Args* ArgsP;
__device__ __forceinline__ ArgsP get_args() { ArgsP p = (ArgsP)__builtin_amdgcn_kernarg_segment_ptr(); asm volatile("" : "+s"(p)); return p; }
#define WSP(T, off) ((T*)(ws + (off)))

#define PHASE_BEGIN if (ph >= lo && ph < hi) { ArgsP ap = get_args(); unsigned char* ws = ap->ws; (void)ws;
#define PHASE_END   if (ph + 1 < hi) xcd_barrier(bar); } ++ph;
#define P_X WSP(float, WS_X)
#define P_H WSP(bf16_t, WS_H)
#define P_BIG WSP(bf16_t, WS_BIG)
#define P_MIX WSP(bf16_t, WS_MIX)
#define P_QF WSP(bf16_t, WS_QF)
#define P_KF WSP(bf16_t, WS_KF)
#define P_VT WSP(bf16_t, WS_VT)
#define P_MODL (WSP(float, WS_MOD) + (size_t)L * 2 * 9216)
template <int L>
__device__ __forceinline__ void layer_body(const XcdBarrier& bar, LAS unsigned char* lds, int& ph, const int lo, const int hi) {
    constexpr bool CTX_A = (L <= 2);
    constexpr bool CTX_B = (L <= 1);
    constexpr int RB_A = CTX_A ? 0 : CTX, M_A = CTX_A ? MT : SEQ;
    constexpr int RB_B = CTX_B ? 0 : CTX, M_B = CTX_B ? MT : SEQ;
    PHASE_BEGIN for (int rep = 0; rep < REP_NORM; ++rep) norm_phase((L == 0) ? ap->in[2] : P_X, (L == 0) ? ap->in[0] : P_X + (size_t)CTX * D, P_H, P_MODL, 0, 1, RB_A); PHASE_END
    PHASE_BEGIN for (int rep = 0; rep < REP_FFNIN; ++rep) { EpiSwiglu E{P_BIG, DFF, RB_A}; run_gemm(lds, P_H + (size_t)RB_A * D, WSP(bf16_t, WS_WIN) + (size_t)(2 * L) * 5632 * 1024, M_A, 2 * DFF, D, E, 0); } PHASE_END
    PHASE_BEGIN {
        const bf16_t* W = WSP(bf16_t, WS_WOUT) + (size_t)(2 * L) * 1024 * 2816;
        for (int rep = 1; rep < REP_FFNOUT; ++rep) { EpiResid E{P_X, WSP(float, WS_QF), P_MODL + 9216 + 2 * D, 0.5f, CTX, CTX, 0}; run_gemm(lds, P_BIG + (size_t)CTX * DFF, W, SEQ, D, DFF, E, 0); }
        { EpiResid E{(L == 0) ? ap->in[0] : P_X, P_X, P_MODL + 9216 + 2 * D, 0.5f, CTX, 0, (L == 0) ? CTX : 0}; run_gemm(lds, P_BIG + (size_t)CTX * DFF, W, SEQ, D, DFF, E, 0); }
        if (CTX_A) ctx_resid<DFF>(lds, P_BIG, W, (L == 0) ? ap->in[2] : P_X, P_X, P_MODL + 2 * D, 0.5f);
    } PHASE_END
    PHASE_BEGIN for (int rep = 0; rep < REP_NORM; ++rep) norm_phase(P_X, P_X + (size_t)CTX * D, P_H, P_MODL, 3, 4, RB_A); PHASE_END
    if (L == 0) {
        PHASE_BEGIN { EpiStore E{WSP(bf16_t, WS_DQKV), 768, 0}; run_gemm(lds, P_H, WSP(bf16_t, WS_MLA_DQKV), MT, 768, D, E, 0); } PHASE_END
        PHASE_BEGIN mla_na_phase(WSP(bf16_t, WS_DQKV), WSP(bf16_t, WS_CQN), WSP(bf16_t, WS_CKVN), P_KF, ap->in[9], ap->in[12], ap->in[18]); PHASE_END
        PHASE_BEGIN {
            { EpiStore E{P_BIG, 1536, 0}; run_gemm(lds, WSP(bf16_t, WS_CQN), WSP(bf16_t, WS_MLA_UQ), MT, 1536, 384, E, 0); }
            { EpiStore E{P_BIG + (size_t)MT * 1536, 1024, 0}; run_gemm(lds, WSP(bf16_t, WS_CKVN), WSP(bf16_t, WS_MLA_UK), MT, 1024, 256, E, 134); }
            { EpiStore E{P_VT, MT, 0}; run_gemm(lds, WSP(bf16_t, WS_MLA_UVT), WSP(bf16_t, WS_CKVN), 1024, MT, 256, E, 138); }
        } PHASE_END
        PHASE_BEGIN mla_nb_phase(P_BIG, P_BIG + (size_t)MT * 1536, P_QF, P_KF, ap->in[15], ap->in[16], ap->in[17], 0.07216878364870322f * LOG2E); PHASE_END
        PHASE_BEGIN attn_mla_phase(lds, P_QF, P_KF, P_VT, P_MIX); PHASE_END
    } else if (L == 1) {
        PHASE_BEGIN pool_phase(P_H, P_MIX); PHASE_END
    } else if (L == 2) {
        PHASE_BEGIN {
            { EpiNaQK E{P_QF, P_KF, ap->in[23], ap->in[24], 0.125f * LOG2E}; run_gemm(lds, P_H, WSP(bf16_t, WS_NA_QK), MT, 2048, D, E, 0); }
            { EpiStore E{P_VT, MT, 0}; run_gemm(lds, WSP(bf16_t, WS_NA_VT), P_H, 1024, MT, D, E, 8); }
        } PHASE_END
        PHASE_BEGIN attn_phase<64, 64, true>(lds, P_QF, P_KF, P_VT, P_MIX, ap->in[25], 16, false); PHASE_END
    } else {
        PHASE_BEGIN { EpiStore E{P_BIG, 3072, CTX}; run_gemm(lds, P_H + (size_t)CTX * D, WSP(bf16_t, WS_CV_IN), SEQ, 3072, D, E, 0); } PHASE_END
        PHASE_BEGIN conv_phase(P_BIG, P_MIX, ap->in[28]); PHASE_END
    }
    PHASE_BEGIN {
        const size_t wo_off = (L == 0) ? WS_MLA_O : (L == 1) ? WS_POOL : (L == 2) ? WS_NA_O : WS_CV_OUT;
        { EpiResid E{P_X, P_X, P_MODL + 9216 + 5 * D, 1.0f, CTX, 0, 0}; run_gemm(lds, P_MIX + (size_t)CTX * D, WSP(bf16_t, wo_off), SEQ, D, D, E, 0); }
        if (CTX_B) ctx_resid<D>(lds, P_MIX, WSP(bf16_t, wo_off), P_X, P_X, P_MODL + 5 * D, 1.0f);
    } PHASE_END
    PHASE_BEGIN for (int rep = 0; rep < REP_NORM; ++rep) norm_phase(P_X, P_X + (size_t)CTX * D, P_H, P_MODL, 6, 7, RB_B); PHASE_END
    PHASE_BEGIN for (int rep = 0; rep < REP_FFNIN; ++rep) { EpiSwiglu E{P_BIG, DFF, RB_B}; run_gemm(lds, P_H + (size_t)RB_B * D, WSP(bf16_t, WS_WIN) + (size_t)(2 * L + 1) * 5632 * 1024, M_B, 2 * DFF, D, E, 0); } PHASE_END
    PHASE_BEGIN {
        const bf16_t* W = WSP(bf16_t, WS_WOUT) + (size_t)(2 * L + 1) * 1024 * 2816;
        { EpiResid E{P_X, (L == 3) ? ap->out : P_X, P_MODL + 9216 + 8 * D, 0.5f, CTX, (L == 3) ? CTX : 0, 0}; run_gemm(lds, P_BIG + (size_t)CTX * DFF, W, SEQ, D, DFF, E, 0); }
        if (CTX_B) ctx_resid<DFF>(lds, P_BIG, W, P_X, P_X, P_MODL + 8 * D, 0.5f);
    } if (L < 3 && ph + 1 < hi) xcd_barrier(bar); } ++ph;
}
__global__ void __launch_bounds__(NTHR, 2) fwd_megakernel(Args args_unused) {
    extern __shared__ __attribute__((aligned(16))) unsigned char lds_raw[];
    LAS unsigned char* lds = (LAS unsigned char*)lds_raw;
    cg::grid_group grid = cg::this_grid();
    int lo, hi; unsigned* barw; { ArgsP ap0 = get_args(); lo = ap0->ph_lo; hi = ap0->ph_hi; barw = (unsigned*)(ap0->ws + WS_BAR); }
    if (lo > hi) grid.sync();
    volatile LAS unsigned* bst = (volatile LAS unsigned*)(lds + 131072);
    if (threadIdx.x < 4) bst[threadIdx.x] = 0u;
    __syncthreads();
    const XcdBarrier bar = xcd_barrier_post(barw, bst);
    int ph = 0;

    PHASE_BEGIN
    for (int rep = 0; rep < REP_P0; ++rep) {
        const int tid = opaque_tid(), lane = tid & 63, wave = tid >> 6;
        bf16_t* WIN = WSP(bf16_t, WS_WIN); bf16_t* WOUT = WSP(bf16_t, WS_WOUT); bf16_t* W_DQKV = WSP(bf16_t, WS_MLA_DQKV); bf16_t* W_POOL = WSP(bf16_t, WS_POOL);
        float* MODP = WSP(float, WS_MODP);
        ConvCtx c; c.base = 0; c.gw = blockIdx.x * NWAVE + wave; c.ngw = gridDim.x * NWAVE; c.lane = lane; c.scr = (LAS float*)(lds + wave * 16384);
        for (int lf = 0; lf < 8; ++lf) {
            conv_job(c, ap->in[6] + (size_t)lf * 1024 * 5632, 5632, 1024, 0, 5632, WIN + (size_t)lf * 5632 * 1024, 1024, 0, 0, nullptr, 1);
            conv_job(c, ap->in[7] + (size_t)lf * 2816 * 1024, 1024, 2816, 0, 1024, WOUT + (size_t)lf * 1024 * 2816, 2816, 0, 0, nullptr, 0);
        }
        conv_job(c, ap->in[8], 384, 1024, 0, 384, W_DQKV, 1024, 0, 0, nullptr, 0);
        conv_job(c, ap->in[11], 320, 1024, 0, 320, W_DQKV, 1024, 384, 0, nullptr, 0);
        conv_job(c, ap->in[10], 1536, 384, 0, 1536, WSP(bf16_t, WS_MLA_UQ), 384, 0, 0, nullptr, 0);
        conv_job(c, ap->in[13], 1024, 256, 0, 1024, WSP(bf16_t, WS_MLA_UK), 256, 0, 0, nullptr, 0);
        conv_job(c, ap->in[14], 1024, 256, 0, 1024, WSP(bf16_t, WS_MLA_UVT), 256, 0, 0, nullptr, 0);
        conv_job(c, ap->in[19], 1024, 1024, 0, 1024, WSP(bf16_t, WS_MLA_O), 1024, 0, 0, nullptr, 0);
        for (int g = 0; g < 4; ++g) conv_job(c, ap->in[20] + (size_t)g * 65536, 256, 256, 0, 256, W_POOL, 1024, g * 256, g * 256, ap->in[21], 0);
        conv_job(c, ap->in[22], 3072, 1024, 0, 2048, WSP(bf16_t, WS_NA_QK), 1024, 0, 0, nullptr, 2);
        conv_job(c, ap->in[22], 3072, 1024, 2048, 1024, WSP(bf16_t, WS_NA_VT), 1024, 0, 0, nullptr, 0);
        conv_job(c, ap->in[26], 1024, 1024, 0, 1024, WSP(bf16_t, WS_NA_O), 1024, 0, 0, nullptr, 0);
        conv_job(c, ap->in[27], 3072, 1024, 0, 3072, WSP(bf16_t, WS_CV_IN), 1024, 0, 0, nullptr, 0);
        conv_job(c, ap->in[29], 1024, 1024, 0, 1024, WSP(bf16_t, WS_CV_OUT), 1024, 0, 0, nullptr, 0);
        const long gt = (long)blockIdx.x * NTHR + tid, nt = (long)gridDim.x * NTHR;
        for (long i = gt; i < 64 * 128; i += nt) *((u32x4*)(W_DQKV + (size_t)704 * 1024) + i) = (u32x4){0u, 0u, 0u, 0u};
        for (long i = gt; i < 1024 * 128; i += nt) { const int row = (int)(i >> 7), ch = (int)(i & 127); if ((row >> 8) != (ch >> 5)) *((u32x4*)(W_POOL + (size_t)row * 1024) + ch) = (u32x4){0u, 0u, 0u, 0u}; }
        const float* mw = ap->in[4]; const float* cctx = ap->in[3]; const float* clat = ap->in[1];
        for (int it = blockIdx.x; it < 4 * 9 * 32; it += gridDim.x) {
            const int l = it / 288, jb = (it % 288) / 32, kc = it % 32, j = jb * 1024 + 2 * tid;
            const float* w = mw + ((size_t)l * 1024 + kc * 32) * 9216 + j;
            float a0 = 0.f, a1 = 0.f, b0 = 0.f, b1 = 0.f;
#pragma unroll 8
            for (int k = 0; k < 32; ++k) { const f32v2 wv = *(const f32v2*)(w + (size_t)k * 9216);
                const float cc = cctx[kc * 32 + k], cl = clat[kc * 32 + k];
                const float sc = cc / (1.f + __expf(-cc)), sl = cl / (1.f + __expf(-cl));
                a0 += sc * wv.x; a1 += sc * wv.y; b0 += sl * wv.x; b1 += sl * wv.y; }
            float* p = MODP + ((size_t)(l * 32 + kc) * 2) * 9216 + j;
            *(f32v2*)p = (f32v2){a0, a1}; *(f32v2*)(p + 9216) = (f32v2){b0, b1};
        }
    }
    PHASE_END
    PHASE_BEGIN
    {
        const int tid = opaque_tid();
        const float* MODP = WSP(float, WS_MODP); float* MOD = WSP(float, WS_MOD); const float* mb = ap->in[5];
        const long gt = (long)blockIdx.x * NTHR + tid, nt = (long)gridDim.x * NTHR;
        for (long i = gt; i < 4 * 2 * 9216; i += nt) { const int l = (int)(i / 18432), s = (int)((i / 9216) & 1), j = (int)(i % 9216);
            float a = mb[l * 9216 + j];
#pragma unroll
            for (int kc = 0; kc < 32; ++kc) a += MODP[((size_t)(l * 32 + kc) * 2 + s) * 9216 + j];
            MOD[i] = a; }
    }
    PHASE_END

    layer_body<0>(bar, lds, ph, lo, hi);
    layer_body<1>(bar, lds, ph, lo, hi);
    layer_body<2>(bar, lds, ph, lo, hi);
    layer_body<3>(bar, lds, ph, lo, hi);
}

extern "C" void kernel_launch(void* const* d_in, const int* in_sizes, int n_in, void* d_out, int out_size, void* d_ws, size_t ws_size, hipStream_t stream) {
    static int grid_blocks = 0;
    if (grid_blocks == 0) {
        if (n_in != 30 || out_size != SEQ * D || ws_size < WS_END) { fprintf(stderr, "kernel_launch: unexpected shapes (n_in %d out %d ws %zu need %zu)\n", n_in, out_size, ws_size, (size_t)WS_END); grid_blocks = -1; return; }
        int dev = 0, cus = 0, per_cu = 0;
        hipGetDevice(&dev);
        hipDeviceGetAttribute(&cus, hipDeviceAttributeMultiprocessorCount, dev);
        if (hipFuncSetAttribute((const void*)fwd_megakernel, hipFuncAttributeMaxDynamicSharedMemorySize, LDS_BYTES) != hipSuccess) { fprintf(stderr, "kernel_launch: hipFuncSetAttribute failed\n"); grid_blocks = -1; return; }
        if (hipOccupancyMaxActiveBlocksPerMultiprocessor(&per_cu, (const void*)fwd_megakernel, NTHR, LDS_BYTES) != hipSuccess || per_cu < 1) { fprintf(stderr, "kernel_launch: occupancy query failed (%d)\n", per_cu); per_cu = 1; (void)hipGetLastError(); }
        grid_blocks = cus * 1;
        (void)per_cu;
    }
    if (grid_blocks < 0) return;
    if (hipMemsetAsync((unsigned char*)d_ws + WS_BAR, 0, (size_t)XCD_BAR_WORDS * 4, stream) != hipSuccess) { fprintf(stderr, "kernel_launch: memset of the barrier words failed\n"); return; }
    Args a{};
    for (int i = 0; i < 30; ++i) a.in[i] = (const float*)d_in[i];
    a.out = (float*)d_out; a.ws = (unsigned char*)d_ws; a.ph_lo = 0; a.ph_hi = 1 << 20;
    void* kargs[] = {&a};
    hipError_t e = hipLaunchCooperativeKernel((const void*)fwd_megakernel, dim3(grid_blocks), dim3(NTHR), kargs, LDS_BYTES, stream);
    if (e != hipSuccess) fprintf(stderr, "kernel_launch: cooperative launch failed: %s (grid %d)\n", hipGetErrorString(e), grid_blocks);
}
```

```cpp
#include <hip/hip_runtime.h>
#include <hip/hip_cooperative_groups.h>
#include <cstdio>
#include <cstdint>
namespace cg = cooperative_groups;
__device__ __forceinline__ int opaque_tid() { int t = (int)threadIdx.x; asm volatile("" : "+v"(t)); return t; }
#define LAS __attribute__((address_space(3)))
#define XB_TMO      128
#define XB_XCNT(j)  (256  + 64 * (j))
#define XB_XSUB(j)  (1280 + 64 * (j))
#define XB_XGEN(j)  (2304 + 64 * (j))
#define XB_TOP      3328
#define XB_TOPGEN   3392
#define XCD_BAR_WORDS 3456
#define XB_SPIN_CAP (1u << 18)

__device__ __forceinline__ unsigned xb_ld(unsigned* p)              { return __hip_atomic_load(p, __ATOMIC_RELAXED, __HIP_MEMORY_SCOPE_AGENT); }
__device__ __forceinline__ unsigned xb_add(unsigned* p, unsigned v) { return __hip_atomic_fetch_add(p, v, __ATOMIC_RELAXED, __HIP_MEMORY_SCOPE_AGENT); }
__device__ __forceinline__ unsigned xb_xcc_id() { return (unsigned)__builtin_amdgcn_s_getreg((3 << 11) | 20) & 0xFu; }
#define XB_SPIN(cond, bar) do { unsigned _sp = 0; while (cond) { __builtin_amdgcn_s_sleep(1); \
    if ((++_sp & 255u) == 0u) { if (xb_ld(&(bar)[XB_TMO])) break; if (_sp > XB_SPIN_CAP) { atomicAdd(&(bar)[XB_TMO], 1u); break; } } } } while (0)

struct XcdBarrier {
    unsigned* bar; unsigned x;
    volatile LAS unsigned* st;
};

__device__ __forceinline__ XcdBarrier xcd_barrier_post(unsigned* bar, volatile LAS unsigned* st) {
    XcdBarrier b; b.bar = bar; b.x = xb_xcc_id(); b.st = st;
    if (threadIdx.x == 0) (void)xb_add(&bar[XB_XCNT(b.x)], 1u);
    return b;
}
__device__ __forceinline__ void xcd_barrier_complete(unsigned* bar, unsigned x, unsigned& nloc, unsigned& nx) {
    const unsigned G = gridDim.x * gridDim.y * gridDim.z;
    unsigned sum, cnt, mine, sp = 0u;
    for (;;) {
        sum = 0u; cnt = 0u; mine = 0u;
#pragma unroll
        for (unsigned j = 0; j < 16; ++j) { const unsigned c = xb_ld(&bar[XB_XCNT(j)]); sum += c; cnt += (c > 0u) ? 1u : 0u; mine = (j == x) ? c : mine; }
        if (sum == G) break;
        __builtin_amdgcn_s_sleep(1);
        if ((++sp & 255u) == 0u) { if (xb_ld(&bar[XB_TMO])) break; if (sp > XB_SPIN_CAP) { atomicAdd(&bar[XB_TMO], 1u); break; } }
    }
    nloc = mine > 0u ? mine : 1u; nx = cnt > 0u ? cnt : 1u;
}

__device__ __forceinline__ void xcd_barrier(const XcdBarrier& b) {
    asm volatile("s_waitcnt vmcnt(0)" ::: "memory");
    __syncthreads();
    if (threadIdx.x == 0) {
        unsigned* bar = b.bar;
        __builtin_amdgcn_s_waitcnt(0);
        unsigned nloc = b.st[0], nx = b.st[1];
        if (nloc == 0u) { xcd_barrier_complete(bar, b.x, nloc, nx); b.st[0] = nloc; b.st[1] = nx; }
        const unsigned old = xb_add(&bar[XB_XSUB(b.x)], 1u);
        const unsigned gen = old / nloc;
        if (old + 1u == (gen + 1u) * nloc) {
            __builtin_amdgcn_fence(__ATOMIC_RELEASE, "agent");
            asm volatile("s_waitcnt vmcnt(0)" ::: "memory");
            const unsigned og = xb_add(&bar[XB_TOP], 1u);
            const unsigned tg = og / nx;
            if (og + 1u == (tg + 1u) * nx) xb_add(&bar[XB_TOPGEN], 1u);
            else XB_SPIN(xb_ld(&bar[XB_TOPGEN]) == tg, bar);
            __builtin_amdgcn_fence(__ATOMIC_ACQUIRE, "agent");
            xb_add(&bar[XB_XGEN(b.x)], 1u);
            asm volatile("s_waitcnt vmcnt(0)" ::: "memory");
        } else {
            XB_SPIN(xb_ld(&bar[XB_XGEN(b.x)]) == gen, bar);
            __builtin_amdgcn_fence(__ATOMIC_ACQUIRE, "agent");
            asm volatile("s_waitcnt vmcnt(0)" ::: "memory");
        }
    }
    __syncthreads();
}
namespace pg8 {
#define PG8_LAS __attribute__((address_space(3)))
typedef unsigned short bf16_t;
typedef short bf16x8 __attribute__((ext_vector_type(8)));
typedef float f32x4 __attribute__((ext_vector_type(4)));
typedef unsigned u32x4 __attribute__((ext_vector_type(4)));
constexpr int BM = 256, BK = 64, HALF = 128, HTB = HALF * BK * 2  , STAGE_BYTES = 8 * HTB, NXCD = 8, WGM = 8;

__host__ __device__ __forceinline__ int lds_byte(int r, int c) { const int st = (r >> 4) * 2 + (c >> 5), rr = r & 15, cc = c & 31, ob = rr * 64 + cc * 2; return st * 1024 + (ob ^ (((ob >> 9) & 1) << 5)); }
__host__ __device__ __forceinline__ void stage_rc(int b, int& R, int& C) { const int st = b / 1024, sb = b % 1024, swz = sb ^ (((sb >> 9) & 1) << 5); R = (st >> 1) * 16 + swz / 64; C = (st & 1) * 32 + (swz % 64) / 2; }
__host__ __device__ __forceinline__ int perm32(int rho) { const int n = rho >> 4, i = rho & 15; return 8 * (i >> 2) + 4 * n + (i & 3); }

struct Unit { int pm, pn; };
struct Gemm { const bf16_t* A; const bf16_t* Bt; int M, N, K; };

struct StaticOrder {
    int nM, nN, nwg, G, c;
    __host__ __device__ void init(int M, int N, int G_, int c_) { nM = M / BM; nN = N / BM; nwg = nM * nN; G = G_; c = c_; }
    __host__ __device__ bool next(int i, Unit& u) const {
        const long L = (long)i * G + c; if (L >= nwg) return false;
        int wgid = (int)L; { const int q = nwg / NXCD, r = nwg % NXCD, xcd = wgid % NXCD, off = wgid / NXCD; wgid = (xcd < r ? xcd * (q + 1) : r * (q + 1) + (xcd - r) * q) + off; }
        const int nig = WGM * nN, gid = wgid / nig, fm = gid * WGM, gsz = (nM - fm) < WGM ? (nM - fm) : WGM;
        u.pm = fm + ((wgid % nig) % gsz); u.pn = (wgid % nig) / gsz; return true;
    }
    __device__ __forceinline__ void a_ready(const Unit&) const {}
    __device__ __forceinline__ void done(const Unit&) const {}
};
__device__ __forceinline__ unsigned cvt_pk_bf16(float lo, float hi) { unsigned r; asm volatile("v_cvt_pk_bf16_f32 %0, %1, %2" : "=v"(r) : "v"(lo), "v"(hi)); return r; }
template <class Epi, class Sched, bool ALIGN_EPI = false, bool SP2 = false>
__device__ __forceinline__ void gemm_phase(PG8_LAS unsigned char* lds, const Gemm g, const Sched& S, const Epi& E) {
    const int tid = opaque_tid(), wid = __builtin_amdgcn_readfirstlane(tid >> 6), lane = tid & 63, wr = wid >> 2, wc = wid & 3, fr = lane & 15, fq = lane >> 4;
    const int K = g.K, nt = K / BK;
    unsigned voffA[2], voffB[2];
#pragma unroll
    for (int i = 0; i < 2; ++i) { int R, C; stage_rc(tid * 16 + i * 8192, R, C); const int Rb = Epi::PERM ? ((R & ~31) + perm32(R & 31)) : R;
        voffA[i] = (unsigned)(R * K + C) * 2u; voffB[i] = (unsigned)(Rb * K + C) * 2u; }
    const size_t kstep = (size_t)(BK * 2);
    const size_t hstep = (size_t)HALF * K * 2;
    const size_t tstep = 2 * hstep;
    const unsigned ldsw = (unsigned)wid * 1024u;
    const int aoff = lds_byte(wr * 64 + fr, fq * 8), boff = lds_byte(wc * 32 + fr, fq * 8);
#define PG8_SA(b, h) (((b) * 2 + (h)) * HTB)
#define PG8_SB(b, h) ((4 + (b) * 2 + (h)) * HTB)
#define PG8_STAGE(bufoff, gbase, voff) do { _Pragma("unroll") for (int _i = 0; _i < 2; ++_i) \
        __builtin_amdgcn_global_load_lds((const unsigned*)((const char*)(gbase) + (voff)[_i]), (PG8_LAS unsigned*)(lds + (bufoff) + ldsw + _i * 8192), 16, 0, 0); } while (0)
#define PG8_LDA(dst, b, h) do { _Pragma("unroll") for (int m = 0; m < 4; ++m) _Pragma("unroll") for (int k = 0; k < 2; ++k) dst[m][k] = *(const PG8_LAS bf16x8*)(lds + PG8_SA(b, h) + aoff + m * 2048 + k * 1024); } while (0)
#define PG8_LDB(dst, b, h) do { _Pragma("unroll") for (int n = 0; n < 2; ++n) _Pragma("unroll") for (int k = 0; k < 2; ++k) dst[n][k] = *(const PG8_LAS bf16x8*)(lds + PG8_SB(b, h) + boff + n * 2048 + k * 1024); } while (0)
#define PG8_MMA(ai, bj, At, Bt) do { __builtin_amdgcn_s_setprio(1); _Pragma("unroll") for (int m = 0; m < 4; ++m) _Pragma("unroll") for (int n = 0; n < 2; ++n) _Pragma("unroll") for (int k = 0; k < 2; ++k) \
        acc[ai][bj][m][n] = __builtin_amdgcn_mfma_f32_16x16x32_bf16(Bt[n][k], At[m][k], acc[ai][bj][m][n], 0, 0, 0); __builtin_amdgcn_s_setprio(0); } while (0)
#define PG8_WAIT_V(n) asm volatile("s_waitcnt vmcnt(" #n ")" ::: "memory")
#define PG8_WAIT_L(n) asm volatile("s_waitcnt lgkmcnt(" #n ")" ::: "memory")
#define PG8_BAR __builtin_amdgcn_s_barrier()
#define PG8_SCHED __builtin_amdgcn_sched_barrier(0)
    Unit cur, nxt; int ui = 0;
    if (!S.next(0, cur)) return;
    f32x4 acc[2][2][4][2];
#pragma unroll
    for (int a = 0; a < 2; ++a)
#pragma unroll
        for (int b = 0; b < 2; ++b)
#pragma unroll
            for (int m = 0; m < 4; ++m)
#pragma unroll
                for (int n = 0; n < 2; ++n) acc[a][b][m][n] = (f32x4){0.f, 0.f, 0.f, 0.f};
    bf16x8 At[4][2], B0[2][2], B1[2][2];
    const char* cA = (const char*)g.A + (size_t)cur.pm * tstep; const char* cB = (const char*)g.Bt + (size_t)cur.pn * tstep;
    S.a_ready(cur);
    if constexpr (SP2) {
        PG8_STAGE(PG8_SB(0, 0), cB, voffB); PG8_STAGE(PG8_SB(0, 1), cB + hstep, voffB); PG8_STAGE(PG8_SA(0, 0), cA, voffA); PG8_STAGE(PG8_SA(0, 1), cA + hstep, voffA);
        if (wr == 1) PG8_BAR;
        PG8_WAIT_V(2); PG8_BAR;
        PG8_STAGE(PG8_SB(1, 0), cB + kstep, voffB); PG8_STAGE(PG8_SA(1, 0), cA + kstep, voffA); PG8_STAGE(PG8_SB(1, 1), cB + hstep + kstep, voffB);
        PG8_WAIT_V(6); PG8_BAR;
    } else {
        PG8_STAGE(PG8_SB(0, 0), cB, voffB); PG8_STAGE(PG8_SA(0, 0), cA, voffA); PG8_STAGE(PG8_SB(0, 1), cB + hstep, voffB); PG8_STAGE(PG8_SA(0, 1), cA + hstep, voffA);
        if (wr == 1) PG8_BAR;
        PG8_WAIT_V(4); PG8_BAR;
        PG8_STAGE(PG8_SB(1, 0), cB + kstep, voffB); PG8_STAGE(PG8_SA(1, 0), cA + kstep, voffA); PG8_STAGE(PG8_SB(1, 1), cB + hstep + kstep, voffB);
        PG8_WAIT_V(6); PG8_BAR;
    }
    for (;;) {
        const bool has_next = S.next(ui + 1, nxt);
        const char* nA = has_next ? (const char*)g.A + (size_t)nxt.pm * tstep : cA; const char* nB = has_next ? (const char*)g.Bt + (size_t)nxt.pn * tstep : cB;
        for (int t = 0; t < nt; t += 2) {
            const bool last = (t == nt - 2);
            const char* a1 = cA + (size_t)(t + 1) * kstep;
            const char* a2 = last ? nA : cA + (size_t)(t + 2) * kstep; const char* b2 = last ? nB : cB + (size_t)(t + 2) * kstep;
            const char* a3 = a2 + kstep; const char* b3 = b2 + kstep;
            if (last && has_next) S.a_ready(nxt);
            if constexpr (SP2) {
            PG8_LDB(B0, 0, 0); PG8_LDB(B1, 0, 1); PG8_SCHED; PG8_LDA(At, 0, 0); PG8_STAGE(PG8_SA(1, 1), a1 + hstep, voffA);
            PG8_WAIT_V(8); PG8_WAIT_L(0); PG8_BAR; PG8_MMA(0, 0, At, B0); PG8_MMA(0, 1, At, B1); PG8_BAR; PG8_SCHED;
            PG8_LDA(At, 0, 1); PG8_STAGE(PG8_SB(0, 0), b2, voffB); PG8_STAGE(PG8_SB(0, 1), b2 + hstep, voffB); PG8_STAGE(PG8_SA(0, 0), a2, voffA);
            PG8_WAIT_V(8); PG8_WAIT_L(0); PG8_BAR; PG8_MMA(1, 0, At, B0); PG8_MMA(1, 1, At, B1); PG8_BAR; PG8_SCHED;
            PG8_LDB(B0, 1, 0); PG8_LDB(B1, 1, 1); PG8_SCHED; PG8_LDA(At, 1, 0); PG8_STAGE(PG8_SA(0, 1), a2 + hstep, voffA);
            PG8_WAIT_V(8); PG8_WAIT_L(0); PG8_BAR; PG8_MMA(0, 0, At, B0); PG8_MMA(0, 1, At, B1); PG8_BAR; PG8_SCHED;
            PG8_LDA(At, 1, 1); PG8_STAGE(PG8_SB(1, 0), b3, voffB); PG8_STAGE(PG8_SB(1, 1), b3 + hstep, voffB); PG8_STAGE(PG8_SA(1, 0), a3, voffA);
            PG8_WAIT_V(8); PG8_WAIT_L(0); PG8_BAR; PG8_MMA(1, 0, At, B0); PG8_MMA(1, 1, At, B1); PG8_BAR; PG8_SCHED;
            } else {
            PG8_LDB(B0, 0, 0); PG8_SCHED; PG8_LDA(At, 0, 0); PG8_STAGE(PG8_SA(1, 1), a1 + hstep, voffA);
            PG8_WAIT_L(8); PG8_BAR; PG8_WAIT_L(0); PG8_MMA(0, 0, At, B0); PG8_BAR; PG8_SCHED;
            PG8_LDB(B1, 0, 1); PG8_STAGE(PG8_SB(0, 0), b2, voffB);
            PG8_BAR; PG8_WAIT_L(0); PG8_MMA(0, 1, At, B1); PG8_BAR;
            PG8_LDA(At, 0, 1); PG8_STAGE(PG8_SA(0, 0), a2, voffA);
            PG8_BAR; PG8_WAIT_L(0); PG8_MMA(1, 0, At, B0); PG8_BAR; PG8_SCHED;
            PG8_STAGE(PG8_SB(0, 1), b2 + hstep, voffB);
            PG8_WAIT_V(6); PG8_BAR; PG8_MMA(1, 1, At, B1); PG8_BAR;
            PG8_LDB(B0, 1, 0); PG8_SCHED; PG8_LDA(At, 1, 0); PG8_STAGE(PG8_SA(0, 1), a2 + hstep, voffA);
            PG8_WAIT_L(8); PG8_BAR; PG8_WAIT_L(0); PG8_MMA(0, 0, At, B0); PG8_BAR; PG8_SCHED;
            PG8_LDB(B1, 1, 1); PG8_STAGE(PG8_SB(1, 0), b3, voffB);
            PG8_BAR; PG8_WAIT_L(0); PG8_MMA(0, 1, At, B1); PG8_BAR;
            PG8_LDA(At, 1, 1); PG8_STAGE(PG8_SA(1, 0), a3, voffA);
            PG8_BAR; PG8_WAIT_L(0); PG8_MMA(1, 0, At, B0); PG8_BAR; PG8_SCHED;
            PG8_STAGE(PG8_SB(1, 1), b3 + hstep, voffB);
            PG8_WAIT_V(6); PG8_BAR; PG8_MMA(1, 1, At, B1); PG8_BAR;
            }
        }
        if constexpr (ALIGN_EPI) { if (wr == 0) PG8_BAR; }
        if constexpr (!Epi::AFTER_DRAIN) { E(acc, cur, wr, wc, fr, fq); S.done(cur); }
        if (!has_next) break;
#pragma unroll
        for (int a = 0; a < 2; ++a)
#pragma unroll
            for (int b = 0; b < 2; ++b)
#pragma unroll
                for (int m = 0; m < 4; ++m)
#pragma unroll
                    for (int n = 0; n < 2; ++n) acc[a][b][m][n] = (f32x4){0.f, 0.f, 0.f, 0.f};
        cur = nxt; cA = nA; cB = nB; ++ui;
        if constexpr (ALIGN_EPI) { if (wr == 1) PG8_BAR; }
    }
    PG8_WAIT_V(0);
    if constexpr (!ALIGN_EPI) { if (wr == 0) PG8_BAR; }
    PG8_BAR;
    if constexpr (Epi::AFTER_DRAIN) { E.fused(acc, cur, wr, wc, fr, fq, lds, wid, lane); S.done(cur); }
#undef PG8_SA
#undef PG8_SB
#undef PG8_STAGE
#undef PG8_LDA
#undef PG8_LDB
#undef PG8_MMA
#undef PG8_WAIT_V
#undef PG8_WAIT_L
#undef PG8_BAR
#undef PG8_SCHED
}
}

using pg8::bf16_t; using pg8::bf16x8; using pg8::f32x4; using pg8::u32x4; using pg8::Unit;
typedef float f32x16 __attribute__((ext_vector_type(16)));
typedef unsigned u32x2 __attribute__((ext_vector_type(2)));
typedef __bf16 bf16v2 __attribute__((ext_vector_type(2)));
typedef float f32v2 __attribute__((ext_vector_type(2)));
typedef short s16x4 __attribute__((ext_vector_type(4)));

constexpr int SEQ = 16384, CTX = 256, MT = SEQ + CTX, D = 1024, DFF = 2816;
constexpr int NTHR = 512, NWAVE = 8;
constexpr int REP_NORM = 1, REP_FFNIN = 1, REP_FFNOUT = 1, REP_P0 = 1;
constexpr int LDS_BYTES = 131072 + 256;
constexpr float EPS = 1e-6f;
constexpr float LOG2E = 1.4426950408889634f;

__device__ __forceinline__ unsigned pk2(float a, float b) { f32v2 v = {a, b}; return __builtin_bit_cast(unsigned, __builtin_convertvector(v, bf16v2)); }
__device__ __forceinline__ float bf_lo(unsigned u) { return __uint_as_float(u << 16); }
__device__ __forceinline__ float bf_hi(unsigned u) { return __uint_as_float(u & 0xffff0000u); }
__device__ __forceinline__ float bf1(bf16_t h) { return __uint_as_float(((unsigned)h) << 16); }
__device__ __forceinline__ bf16_t f2bf(float f) { return (bf16_t)(pk2(f, 0.f) & 0xffffu); }
__device__ __forceinline__ float wave_sum(float v) {
#pragma unroll
    for (int o = 1; o < 64; o <<= 1) v += __shfl_xor(v, o);
    return v;
}
#define LDS_WAIT() asm volatile("s_waitcnt lgkmcnt(0)" ::: "memory")

constexpr size_t al256(size_t x) { return (x + 255) & ~(size_t)255; }
constexpr size_t WS_X = 0;
constexpr size_t WS_H = WS_X + al256((size_t)MT * D * 4);
constexpr size_t WS_BIG = WS_H + al256((size_t)MT * D * 2);
constexpr size_t WS_MIX = WS_BIG + al256((size_t)MT * 3072 * 2);
constexpr size_t WS_DQKV = WS_MIX + al256((size_t)MT * D * 2);
constexpr size_t WS_CQN = WS_DQKV + al256((size_t)MT * 768 * 2);
constexpr size_t WS_CKVN = WS_CQN + al256((size_t)MT * 384 * 2);
constexpr size_t WS_QF = WS_CKVN + al256((size_t)MT * 256 * 2);
constexpr size_t WS_KF = WS_QF + al256((size_t)8 * MT * 192 * 2);
constexpr size_t WS_VT = WS_KF + al256((size_t)8 * MT * 192 * 2);
constexpr size_t WS_MODP = WS_VT + al256((size_t)1024 * MT * 2);
constexpr size_t WS_MOD = WS_MODP + al256((size_t)4 * 32 * 2 * 9216 * 4);
constexpr size_t WS_WIN = WS_MOD + al256((size_t)4 * 2 * 9216 * 4);
constexpr size_t WS_WOUT = WS_WIN + al256((size_t)8 * 5632 * 1024 * 2);
constexpr size_t WS_MLA_DQKV = WS_WOUT + al256((size_t)8 * 1024 * 2816 * 2);
constexpr size_t WS_MLA_UQ = WS_MLA_DQKV + al256((size_t)768 * 1024 * 2);
constexpr size_t WS_MLA_UK = WS_MLA_UQ + al256((size_t)1536 * 384 * 2);
constexpr size_t WS_MLA_UVT = WS_MLA_UK + al256((size_t)1024 * 256 * 2);
constexpr size_t WS_MLA_O = WS_MLA_UVT + al256((size_t)1024 * 256 * 2);
constexpr size_t WS_POOL = WS_MLA_O + al256((size_t)1024 * 1024 * 2);
constexpr size_t WS_NA_QK = WS_POOL + al256((size_t)1024 * 1024 * 2);
constexpr size_t WS_NA_VT = WS_NA_QK + al256((size_t)2048 * 1024 * 2);
constexpr size_t WS_NA_O = WS_NA_VT + al256((size_t)1024 * 1024 * 2);
constexpr size_t WS_CV_IN = WS_NA_O + al256((size_t)1024 * 1024 * 2);
constexpr size_t WS_CV_OUT = WS_CV_IN + al256((size_t)3072 * 1024 * 2);
constexpr size_t WS_BAR = WS_CV_OUT + al256((size_t)1024 * 1024 * 2);
constexpr size_t WS_END = WS_BAR + al256((size_t)XCD_BAR_WORDS * 4);

struct EpiStore {
    static constexpr bool PERM = true, AFTER_DRAIN = false;
    bf16_t* O; int ldc; int row_base;
    __device__ __forceinline__ void operator()(const f32x4 (&acc)[2][2][4][2], const Unit& u, int wr, int wc, int fr, int fq) const {
        const int row0 = row_base + u.pm * 256 + wr * 64 + fr, col0 = u.pn * 256 + wc * 32 + 8 * fq;
#pragma unroll
        for (int ai = 0; ai < 2; ++ai)
#pragma unroll
            for (int m = 0; m < 4; ++m) { bf16_t* rowp = O + (size_t)(row0 + ai * 128 + m * 16) * ldc + col0;
#pragma unroll
                for (int bj = 0; bj < 2; ++bj) { const f32x4 v0 = acc[ai][bj][m][0], v1 = acc[ai][bj][m][1];
                    u32x4 w; w.x = pk2(v0[0], v0[1]); w.y = pk2(v0[2], v0[3]); w.z = pk2(v1[0], v1[1]); w.w = pk2(v1[2], v1[3]);
                    *(u32x4*)(rowp + bj * 128) = w; } }
    }
};
__device__ __forceinline__ float silu_f(float g) { return g * __builtin_amdgcn_rcpf(1.f + __expf(-g)); }
struct EpiSwiglu {
    static constexpr bool PERM = true, AFTER_DRAIN = false;
    bf16_t* O; int ldc; int row_base;
    __device__ __forceinline__ void operator()(const f32x4 (&acc)[2][2][4][2], const Unit& u, int wr, int wc, int fr, int fq) const {
        const int row0 = row_base + u.pm * 256 + wr * 64 + fr, col0 = u.pn * 128 + wc * 32 + 8 * fq;
#pragma unroll
        for (int ai = 0; ai < 2; ++ai)
#pragma unroll
            for (int m = 0; m < 4; ++m) { bf16_t* rowp = O + (size_t)(row0 + ai * 128 + m * 16) * ldc + col0;
                const f32x4 g0 = acc[ai][0][m][0], g1 = acc[ai][0][m][1], u0 = acc[ai][1][m][0], u1 = acc[ai][1][m][1];
                u32x4 w;
                w.x = pk2(silu_f(g0[0]) * u0[0], silu_f(g0[1]) * u0[1]); w.y = pk2(silu_f(g0[2]) * u0[2], silu_f(g0[3]) * u0[3]);
                w.z = pk2(silu_f(g1[0]) * u1[0], silu_f(g1[1]) * u1[1]); w.w = pk2(silu_f(g1[2]) * u1[2], silu_f(g1[3]) * u1[3]);
                *(u32x4*)rowp = w; }
    }
};
struct EpiResid {
    static constexpr bool PERM = true, AFTER_DRAIN = false;
    const float* xin; float* xout; const float* gate; float coef; int row_base; int out_row_off; int in_row_off;
    __device__ __forceinline__ void operator()(const f32x4 (&acc)[2][2][4][2], const Unit& u, int wr, int wc, int fr, int fq) const {
        const int row0 = row_base + u.pm * 256 + wr * 64 + fr, col0 = u.pn * 256 + wc * 32 + 8 * fq;
        f32x4 gv[2][2];
#pragma unroll
        for (int bj = 0; bj < 2; ++bj)
#pragma unroll
            for (int n = 0; n < 2; ++n) gv[bj][n] = *(const f32x4*)(gate + col0 + bj * 128 + 4 * n) * coef;
#pragma unroll
        for (int ai = 0; ai < 2; ++ai)
#pragma unroll
            for (int m = 0; m < 4; ++m) { const int row = row0 + ai * 128 + m * 16;
                const float* xi = xin + (size_t)(row - in_row_off) * D + col0; float* xo = xout + (size_t)(row - out_row_off) * D + col0;
#pragma unroll
                for (int bj = 0; bj < 2; ++bj)
#pragma unroll
                    for (int n = 0; n < 2; ++n) { const f32x4 xv = *(const f32x4*)(xi + bj * 128 + 4 * n);
                        *(f32x4*)(xo + bj * 128 + 4 * n) = xv + gv[bj][n] * acc[ai][bj][m][n]; } }
    }
};
struct EpiNaQK {
    static constexpr bool PERM = true, AFTER_DRAIN = false;
    bf16_t* QN; bf16_t* KN; const float* g_q; const float* g_k; float qscale;
    __device__ __forceinline__ void operator()(const f32x4 (&acc)[2][2][4][2], const Unit& u, int wr, int wc, int fr, int fq) const {
        const int hh = u.pn * 4 + wc; const bool isq = hh < 16; const int h = hh & 15;
        const float* g = isq ? g_q : g_k; const float sc = isq ? qscale : 1.f;
        bf16_t* outb = (isq ? QN : KN) + (size_t)h * MT * 64;
        f32x4 gv[2][2];
#pragma unroll
        for (int bj = 0; bj < 2; ++bj)
#pragma unroll
            for (int n = 0; n < 2; ++n) gv[bj][n] = *(const f32x4*)(g + 32 * bj + 8 * fq + 4 * n) * sc;
        const int row0 = u.pm * 256 + wr * 64 + fr;
#pragma unroll
        for (int ai = 0; ai < 2; ++ai)
#pragma unroll
            for (int m = 0; m < 4; ++m) { const int row = row0 + ai * 128 + m * 16;
                float ss = 0.f;
#pragma unroll
                for (int bj = 0; bj < 2; ++bj)
#pragma unroll
                    for (int n = 0; n < 2; ++n) { const f32x4 v = acc[ai][bj][m][n]; ss += (v[0] * v[0] + v[1] * v[1]) + (v[2] * v[2] + v[3] * v[3]); }
                ss += __shfl_xor(ss, 16); ss += __shfl_xor(ss, 32);
                const float rinv = rsqrtf(ss * (1.f / 64.f) + EPS);
#pragma unroll
                for (int bj = 0; bj < 2; ++bj) { const f32x4 v0 = acc[ai][bj][m][0] * gv[bj][0] * rinv, v1 = acc[ai][bj][m][1] * gv[bj][1] * rinv;
                    u32x4 w; w.x = pk2(v0[0], v0[1]); w.y = pk2(v0[2], v0[3]); w.z = pk2(v1[0], v1[1]); w.w = pk2(v1[2], v1[3]);
                    *(u32x4*)(outb + (size_t)row * 64 + 32 * bj + 8 * fq) = w; } }
    }
};
struct EpiMulPair {
    static constexpr bool PERM = true, AFTER_DRAIN = false;
    bf16_t* O; int ldc; int row_base;
    __device__ __forceinline__ void operator()(const f32x4 (&acc)[2][2][4][2], const Unit& u, int wr, int wc, int fr, int fq) const {
        const int row0 = row_base + u.pm * 256 + wr * 64 + fr, col0 = u.pn * 128 + wc * 32 + 8 * fq;
#pragma unroll
        for (int ai = 0; ai < 2; ++ai)
#pragma unroll
            for (int m = 0; m < 4; ++m) { bf16_t* rowp = O + (size_t)(row0 + ai * 128 + m * 16) * ldc + col0;
                const f32x4 p0 = acc[ai][0][m][0] * acc[ai][1][m][0], p1 = acc[ai][0][m][1] * acc[ai][1][m][1];
                u32x4 w; w.x = pk2(p0[0], p0[1]); w.y = pk2(p0[2], p0[3]); w.z = pk2(p1[0], p1[1]); w.w = pk2(p1[2], p1[3]);
                *(u32x4*)rowp = w; }
    }
};
template <class Epi>
__device__ __forceinline__ void run_gemm(LAS unsigned char* lds, const bf16_t* A, const bf16_t* Bt, int M, int N, int K, const Epi& E, int rot) {
    pg8::Gemm g{A, Bt, M, N, K}; pg8::StaticOrder S; S.init(M, N, (int)gridDim.x, (int)((blockIdx.x + (unsigned)rot) % gridDim.x));
    pg8::gemm_phase<Epi, pg8::StaticOrder, true, true>(lds, g, S, E);
}

template <int K>
__device__ __forceinline__ void ctx_resid(LAS unsigned char* lds, const bf16_t* __restrict__ A, const bf16_t* __restrict__ Bt, const float* Xin, float* X,
                                          const float* __restrict__ gate, float coef) {
    const int tid = opaque_tid(), wave = tid >> 6, lane = tid & 63, fr = lane & 15, fq = lane >> 4;
    LAS float* part = (LAS float*)lds;
    constexpr int kw = K / 8;
    for (int p = blockIdx.x; p < 256; p += gridDim.x) {
        const int rb = p >> 4, cb = p & 15;
        f32x4 acc[4];
#pragma unroll
        for (int j = 0; j < 4; ++j) acc[j] = (f32x4){0.f, 0.f, 0.f, 0.f};
        const bf16_t* ap = A + (size_t)(16 * rb + fr) * K + wave * kw + 8 * fq;
        const bf16_t* bp = Bt + (size_t)(64 * cb + fr) * K + wave * kw + 8 * fq;
        const int erow = tid >> 5, ecol = (tid & 31) * 2; const size_t xo = (size_t)(16 * rb + erow) * D + 64 * cb + ecol;
        f32v2 xv = *(const f32v2*)(Xin + xo); const f32v2 gvv = *(const f32v2*)(gate + 64 * cb + ecol);
#pragma unroll
        for (int k = 0; k < kw; k += 32) {
            const bf16x8 a = *(const bf16x8*)(ap + k);
#pragma unroll
            for (int j = 0; j < 4; ++j) { const bf16x8 b = *(const bf16x8*)(bp + (size_t)(16 * j) * K + k); acc[j] = __builtin_amdgcn_mfma_f32_16x16x32_bf16(b, a, acc[j], 0, 0, 0); }
        }
#pragma unroll
        for (int j = 0; j < 4; ++j) *(LAS f32x4*)(part + (wave * 16 + fr) * 64 + 16 * j + 4 * fq) = acc[j];
        __syncthreads();
        { float s0 = 0.f, s1 = 0.f;
#pragma unroll
            for (int w = 0; w < 8; ++w) { const f32v2 v = *(const LAS f32v2*)(part + (w * 16 + erow) * 64 + ecol); s0 += v.x; s1 += v.y; }
            xv.x += coef * gvv.x * s0; xv.y += coef * gvv.y * s1; *(f32v2*)(X + xo) = xv; }
        __syncthreads();
    }
}

__device__ __forceinline__ void tr_item(const float* __restrict__ W, int ldw, int k0, int sc0, bf16_t* __restrict__ WT, int ldt, int dr0, int dc0,
                                        const float* __restrict__ scale, LAS float* scr, int lane) {
#pragma unroll 16
    for (int i = 0; i < 32; ++i) { const int kk = 2 * i + (lane >> 5); scr[kk * 33 + (lane & 31)] = W[(size_t)(k0 + kk) * ldw + sc0 + (lane & 31)]; }
    LDS_WAIT();
    const int c = lane & 7;
#pragma unroll
    for (int j = 0; j < 4; ++j) { const int n = (lane >> 3) + 8 * j; const LAS float* s = scr + (8 * c) * 33 + n;
        const float sc = scale ? scale[dr0 + n] : 1.f;
        u32x4 o; o.x = pk2(s[0 * 33] * sc, s[1 * 33] * sc); o.y = pk2(s[2 * 33] * sc, s[3 * 33] * sc); o.z = pk2(s[4 * 33] * sc, s[5 * 33] * sc); o.w = pk2(s[6 * 33] * sc, s[7 * 33] * sc);
        *(u32x4*)(WT + (size_t)(dr0 + n) * ldt + dc0 + k0 + 8 * c) = o; }
    LDS_WAIT();
}
struct ConvCtx { long base; int gw, ngw, lane; LAS float* scr; };
__device__ __forceinline__ void conv_job(ConvCtx& c, const float* W, int ldw, int K, int sc0, int ncols, bf16_t* WT, int ldt, int dr0, int dc0, const float* scale, int mode) {
    const int nblk = ncols / 32; const long n_items = (long)(K / 64) * nblk;
    long rem = ((long)c.gw - c.base) % c.ngw; if (rem < 0) rem += c.ngw;
    for (long g = c.base + rem; g < c.base + n_items; g += c.ngw) {
        const int it = (int)(g - c.base), kb = it / nblk, nb = it % nblk, n0 = 32 * nb;
        int src_col = sc0 + n0;
        if (mode == 1) { const int pn = n0 >> 8, bj = (n0 >> 7) & 1, j0 = n0 & 127; src_col = bj * DFF + 128 * pn + j0; }
        if (mode == 3) { const int pn = n0 >> 8, bj = (n0 >> 7) & 1, j0 = n0 & 127; src_col = sc0 + bj * 1024 + 128 * pn + j0; }
        if (mode == 2) { const int pn = n0 >> 8, bj = (n0 >> 7) & 1, wcc = (n0 >> 5) & 3; src_col = sc0 + (pn * 4 + wcc) * 64 + 32 * bj; }
        tr_item(W, ldw, 64 * kb, src_col, WT, ldt, dr0 + n0, dc0, scale, c.scr, c.lane);
    }
    c.base += n_items;
}

__device__ __forceinline__ void norm_phase(const float* __restrict__ Xc, const float* __restrict__ Xl, bf16_t* __restrict__ H, const float* __restrict__ modL, int i_shift, int i_scale, int row_begin) {
    const int tid_ = opaque_tid(), lane = tid_ & 63, gw = blockIdx.x * NWAVE + (tid_ >> 6), ngw = gridDim.x * NWAVE;
    for (int row = row_begin + gw; row < MT; row += ngw) {
        const float* mp = modL + (row >= CTX ? 9216 : 0);
        const f32x4* xr = (const f32x4*)(row >= CTX ? Xl + (size_t)(row - CTX) * D : Xc + (size_t)row * D) + lane;
        f32x4 v[4]; float ss = 0.f;
#pragma unroll
        for (int j = 0; j < 4; ++j) { v[j] = xr[64 * j]; ss += (v[j].x * v[j].x + v[j].y * v[j].y) + (v[j].z * v[j].z + v[j].w * v[j].w); }
        const float rinv = rsqrtf(wave_sum(ss) * (1.f / D) + EPS);
        u32x2* o = (u32x2*)(H + (size_t)row * D) + lane;
#pragma unroll
        for (int j = 0; j < 4; ++j) {
            const f32x4 sh = *((const f32x4*)(mp + i_shift * D) + lane + 64 * j), sc = *((const f32x4*)(mp + i_scale * D) + lane + 64 * j);
            const f32x4 h = v[j] * rinv * (sc + 1.f) + sh;
            u32x2 w; w.x = pk2(h.x, h.y); w.y = pk2(h.z, h.w); o[64 * j] = w; }
    }
}

__device__ __forceinline__ float rope_elem(float val, float oth, int e, int t) {
    if (t < 0) return val;
    const int p = e >> 1, fi = p & 15;
    const float freq = __builtin_amdgcn_exp2f(-(float)fi * (13.287712379549449f / 16.f));
    const float pos = (p < 16) ? (float)(t >> 6) : (float)(t & 63);
    const float rev = pos * freq * 0.15915494309189535f, fr_ = rev - floorf(rev);
    const float sn = __builtin_amdgcn_sinf(fr_), cs = __builtin_amdgcn_cosf(fr_);
    return (e & 1) ? (oth * sn + val * cs) : (val * cs - oth * sn);
}

__device__ __forceinline__ void mla_na_phase(const bf16_t* __restrict__ R, bf16_t* __restrict__ CQN, bf16_t* __restrict__ CKVN, bf16_t* __restrict__ KF,
                                             const float* __restrict__ g_dq, const float* __restrict__ g_dkv, const float* __restrict__ g_kr) {
    const int tid_ = opaque_tid(), lane = tid_ & 63, gw = blockIdx.x * NWAVE + (tid_ >> 6), ngw = gridDim.x * NWAVE;
    for (int rowa = gw; rowa < MT; rowa += 2 * ngw) {
        int rows[2] = {rowa, min(rowa + ngw, MT - 1)};
        unsigned q[2][3]; u32x2 kv[2]; float kr[2], ss[2], sk[2], sr[2];
#pragma unroll
        for (int u = 0; u < 2; ++u) { const bf16_t* r = R + (size_t)rows[u] * 768;
#pragma unroll
            for (int j = 0; j < 3; ++j) q[u][j] = *((const unsigned*)r + lane + 64 * j);
            kv[u] = *((const u32x2*)(r + 384) + lane); kr[u] = bf1(r[640 + lane]); }
#pragma unroll
        for (int u = 0; u < 2; ++u) { float s_ = 0.f;
#pragma unroll
            for (int j = 0; j < 3; ++j) { const float a = bf_lo(q[u][j]), b = bf_hi(q[u][j]); s_ += a * a + b * b; }
            ss[u] = s_;
            const float k0 = bf_lo(kv[u].x), k1 = bf_hi(kv[u].x), k2 = bf_lo(kv[u].y), k3 = bf_hi(kv[u].y);
            sk[u] = k0 * k0 + k1 * k1 + k2 * k2 + k3 * k3; sr[u] = kr[u] * kr[u]; }
#pragma unroll
        for (int o = 1; o < 64; o <<= 1)
#pragma unroll
            for (int u = 0; u < 2; ++u) { ss[u] += __shfl_xor(ss[u], o); sk[u] += __shfl_xor(sk[u], o); sr[u] += __shfl_xor(sr[u], o); }
#pragma unroll
        for (int u = 0; u < 2; ++u) { const int row = rows[u];
            const float rq = rsqrtf(ss[u] * (1.f / 384.f) + EPS), rk = rsqrtf(sk[u] * (1.f / 256.f) + EPS), rr = rsqrtf(sr[u] * (1.f / 64.f) + EPS);
#pragma unroll
            for (int j = 0; j < 3; ++j) { const int e = 2 * lane + 128 * j;
                *((unsigned*)(CQN + (size_t)row * 384) + lane + 64 * j) = pk2(bf_lo(q[u][j]) * rq * g_dq[e], bf_hi(q[u][j]) * rq * g_dq[e + 1]); }
            const float k0 = bf_lo(kv[u].x), k1 = bf_hi(kv[u].x), k2 = bf_lo(kv[u].y), k3 = bf_hi(kv[u].y);
            u32x2 w; w.x = pk2(k0 * rk * g_dkv[4 * lane], k1 * rk * g_dkv[4 * lane + 1]); w.y = pk2(k2 * rk * g_dkv[4 * lane + 2], k3 * rk * g_dkv[4 * lane + 3]);
            *((u32x2*)(CKVN + (size_t)row * 256) + lane) = w;
            const float val = kr[u] * rr * g_kr[lane], oth = __shfl_xor(val, 1);
            const bf16_t ko = f2bf(rope_elem(val, oth, lane, row - CTX));
#pragma unroll
            for (int h = 0; h < 8; ++h) KF[((size_t)h * MT + row) * 192 + 128 + lane] = ko; }
    }
}
__device__ __forceinline__ void mla_nb_phase(const bf16_t* __restrict__ QR, const bf16_t* __restrict__ KR, bf16_t* __restrict__ QF, bf16_t* __restrict__ KF,
                                             const float* __restrict__ g_qn, const float* __restrict__ g_qr, const float* __restrict__ g_kn, float qscale) {
    const int tid_ = opaque_tid(), lane = tid_ & 63, gw = blockIdx.x * NWAVE + (tid_ >> 6), ngw = gridDim.x * NWAVE;
    const float gq0 = g_qn[2 * lane], gq1 = g_qn[2 * lane + 1], gk0 = g_kn[2 * lane], gk1 = g_kn[2 * lane + 1], gr = g_qr[lane];
    for (int row = gw; row < MT; row += ngw) {
#pragma unroll 4
        for (int h = 0; h < 8; ++h) {
            const bf16_t* q = QR + (size_t)row * 1536 + h * 192;
            const unsigned qn = *((const unsigned*)q + lane); const float qrv = bf1(q[128 + lane]);
            const unsigned kn = *((const unsigned*)(KR + (size_t)row * 1024 + h * 128) + lane);
            const float a = bf_lo(qn), b = bf_hi(qn), c = bf_lo(kn), d = bf_hi(kn);
            const float r1 = rsqrtf(wave_sum(a * a + b * b) * (1.f / 128.f) + EPS);
            const float r2 = rsqrtf(wave_sum(qrv * qrv) * (1.f / 64.f) + EPS);
            const float r3 = rsqrtf(wave_sum(c * c + d * d) * (1.f / 128.f) + EPS);
            bf16_t* qo = QF + ((size_t)h * MT + row) * 192;
            *((unsigned*)qo + lane) = pk2(a * r1 * gq0 * qscale, b * r1 * gq1 * qscale);
            const float val = qrv * r2 * gr, oth = __shfl_xor(val, 1);
            qo[128 + lane] = f2bf(rope_elem(val, oth, lane, row - CTX) * qscale);
            *((unsigned*)(KF + ((size_t)h * MT + row) * 192) + lane) = pk2(c * r3 * gk0, d * r3 * gk1);
        }
    }
}
__device__ __forceinline__ void na_norm_phase(const bf16_t* __restrict__ R, bf16_t* __restrict__ QN, bf16_t* __restrict__ KN,
                                              const float* __restrict__ g_q, const float* __restrict__ g_k, float qscale) {
    const int tid_ = opaque_tid(), lane = tid_ & 63, gw = blockIdx.x * NWAVE + (tid_ >> 6), ngw = gridDim.x * NWAVE;
    const int e0 = 8 * (lane & 7);
    for (int row = gw; row < MT; row += ngw) {
#pragma unroll
        for (int j = 0; j < 4; ++j) {
            const u32x4 v = *((const u32x4*)(R + (size_t)row * 2048 + j * 512) + lane);
            float f[8] = {bf_lo(v.x), bf_hi(v.x), bf_lo(v.y), bf_hi(v.y), bf_lo(v.z), bf_hi(v.z), bf_lo(v.w), bf_hi(v.w)};
            float ss = 0.f;
#pragma unroll
            for (int i = 0; i < 8; ++i) ss += f[i] * f[i];
            ss += __shfl_xor(ss, 1); ss += __shfl_xor(ss, 2); ss += __shfl_xor(ss, 4);
            const float rinv = rsqrtf(ss * (1.f / 64.f) + EPS);
            const int seg = j * 8 + (lane >> 3);
            const bool isq = seg < 16; const int h = seg & 15;
            const float* g = isq ? g_q : g_k; const float sc = isq ? rinv * qscale : rinv;
            u32x4 w; w.x = pk2(f[0] * sc * g[e0], f[1] * sc * g[e0 + 1]); w.y = pk2(f[2] * sc * g[e0 + 2], f[3] * sc * g[e0 + 3]);
            w.z = pk2(f[4] * sc * g[e0 + 4], f[5] * sc * g[e0 + 5]); w.w = pk2(f[6] * sc * g[e0 + 6], f[7] * sc * g[e0 + 7]);
            *(u32x4*)((isq ? QN : KN) + ((size_t)h * MT + row) * 64 + e0) = w;
        }
    }
}
template <int G>
__device__ __forceinline__ void pool_group(const bf16_t* __restrict__ H, bf16_t* __restrict__ Y) {
    constexpr int HALF = 1 << G, W = 2 * HALF;
    const long n = (long)MT * 32, stride = (long)gridDim.x * NTHR;
    for (long idx = (long)blockIdx.x * NTHR + opaque_tid(); idx < n; idx += stride) {
        const int row = (int)(idx >> 5), ch = G * 32 + (int)(idx & 31);
        const int base = row >= CTX ? CTX : 0, T = row >= CTX ? SEQ : CTX, ts = row - base;
        const int lo = max(ts - HALF, 0), hi = min(ts + HALF, T);
        u32x4 v[W];
#pragma unroll
        for (int j = 0; j < W; ++j) { const int r = min(max(ts - HALF + j, 0), T - 1); v[j] = *((const u32x4*)(H + (size_t)(base + r) * D) + ch); }
        const u32x4 c = *((const u32x4*)(H + (size_t)row * D) + ch);
        float s[8] = {0, 0, 0, 0, 0, 0, 0, 0};
#pragma unroll
        for (int j = 0; j < W; ++j) { const int r = ts - HALF + j; const float wgt = (r >= lo && r < hi) ? 1.f : 0.f;
            s[0] += wgt * bf_lo(v[j].x); s[1] += wgt * bf_hi(v[j].x); s[2] += wgt * bf_lo(v[j].y); s[3] += wgt * bf_hi(v[j].y);
            s[4] += wgt * bf_lo(v[j].z); s[5] += wgt * bf_hi(v[j].z); s[6] += wgt * bf_lo(v[j].w); s[7] += wgt * bf_hi(v[j].w); }
        const float inv = 1.f / (float)(hi - lo);
        u32x4 w; w.x = pk2(s[0] * inv - bf_lo(c.x), s[1] * inv - bf_hi(c.x)); w.y = pk2(s[2] * inv - bf_lo(c.y), s[3] * inv - bf_hi(c.y));
        w.z = pk2(s[4] * inv - bf_lo(c.z), s[5] * inv - bf_hi(c.z)); w.w = pk2(s[6] * inv - bf_lo(c.w), s[7] * inv - bf_hi(c.w));
        *((u32x4*)(Y + (size_t)row * D) + ch) = w;
    }
}
__device__ __forceinline__ void pool_phase(const bf16_t* __restrict__ H, bf16_t* __restrict__ Y) {
    pool_group<0>(H, Y); pool_group<1>(H, Y); pool_group<2>(H, Y); pool_group<3>(H, Y);
}
__device__ __forceinline__ void conv_phase(const bf16_t* __restrict__ CU, const bf16_t* __restrict__ Bg, bf16_t* __restrict__ G, const float* __restrict__ cw) {
    const long n = (long)MT * 128, stride = (long)gridDim.x * NTHR;
    for (long idx = (long)CTX * 128 + (long)blockIdx.x * NTHR + opaque_tid(); idx < n; idx += stride) {
        const int row = (int)(idx >> 7), ch = (int)(idx & 127);
        float z[8] = {0, 0, 0, 0, 0, 0, 0, 0};
#pragma unroll
        for (int k = 0; k < 3; ++k) { const int r = row + k - 1;
            if (r >= CTX && r < MT) {
                const u32x4 c = *((const u32x4*)(CU + (size_t)r * D) + ch);
                const f32x4 w0 = *((const f32x4*)(cw + k * D) + 2 * ch), w1 = *((const f32x4*)(cw + k * D) + 2 * ch + 1);
                z[0] += w0.x * bf_lo(c.x); z[1] += w0.y * bf_hi(c.x); z[2] += w0.z * bf_lo(c.y); z[3] += w0.w * bf_hi(c.y);
                z[4] += w1.x * bf_lo(c.z); z[5] += w1.y * bf_hi(c.z); z[6] += w1.z * bf_lo(c.w); z[7] += w1.w * bf_hi(c.w); } }
        const u32x4 b = *((const u32x4*)(Bg + (size_t)row * D) + ch);
        u32x4 w; w.x = pk2(z[0] * bf_lo(b.x), z[1] * bf_hi(b.x)); w.y = pk2(z[2] * bf_lo(b.y), z[3] * bf_hi(b.y));
        w.z = pk2(z[4] * bf_lo(b.z), z[5] * bf_hi(b.z)); w.w = pk2(z[6] * bf_lo(b.w), z[7] * bf_hi(b.w));
        *((u32x4*)(G + (size_t)row * D) + ch) = w;
    }
}

template <int DQK, int DV, bool NA>
__device__ __forceinline__ void attn_phase(LAS unsigned char* lds, const bf16_t* __restrict__ Q, const bf16_t* __restrict__ Kf, const bf16_t* __restrict__ VT,
                                           bf16_t* __restrict__ O, const float* __restrict__ rpb, int H, bool with_ctx) {
    constexpr int KSTR = (DQK + 8) * 2, VSTR = (64 + 8) * 2, KBUF = 64 * KSTR, VBUF = DV * VSTR;
    constexpr int KCH = DQK / 8, NKL = 64 * KCH / NTHR, NVL = DV * 8 / NTHR, NKS = DQK / 16, NDV = DV / 32;
    constexpr int RPB_OFF = 2 * KBUF + 2 * VBUF;
    const int tid = opaque_tid(), wave = tid >> 6, lane = tid & 63, r = lane & 31, hh = lane >> 5;
    LAS float* rpbL = (LAS float*)(lds + RPB_OFF);
    const int nbig = 64 * H, nunits = with_ctx ? 65 * H : 64 * H;
    for (int u = blockIdx.x; u < nunits; u += gridDim.x) {
        int head, qb;
        if (u < nbig) { const int b = u & 255, rnd = u >> 8, xcd = b & 7, slot = b >> 3; head = xcd + 8 * (rnd >> 1); qb = 1 + (rnd & 1) * 32 + slot; }
        else { head = u - nbig; qb = 0; }
        int nloc = 0, rlo = 0, NT;
        if (!NA) NT = (qb == 0) ? 4 : 260;
        else { if (qb > 0) { const int r0 = 4 * (qb - 1); rlo = min(max(r0 - 4, 0), 248); const int rhi = min(max(r0 - 1, 0), 248) + 7; nloc = rhi - rlo + 1; } NT = nloc + 4; }
#define TILE_ROW0(t) (!NA ? 64 * (t) : ((t) < nloc ? CTX + 64 * (rlo + (t)) : 64 * ((t) - nloc)))
        const int qrow = 256 * qb + 32 * wave + r;
        const int rq = 4 * (qb - 1) + (wave >> 1), cq = 32 * (wave & 1) + r;
        const int rs = min(max(rq - 4, 0), 248), cs = min(max(cq - 8, 0), 48);
        bf16x8 qf[NKS];
#pragma unroll
        for (int ks = 0; ks < NKS; ++ks) qf[ks] = *(const bf16x8*)(Q + ((size_t)head * MT + qrow) * DQK + 16 * ks + 8 * hh);
        u32x4 kreg[NKL], vreg[NVL];
#define ATT_LOAD(t) do { const int row0_ = TILE_ROW0(t); \
        _Pragma("unroll") for (int i = 0; i < NKL; ++i) { const int c_ = tid + NTHR * i, kr_ = c_ / KCH, kc_ = c_ % KCH; kreg[i] = *(const u32x4*)(Kf + ((size_t)head * MT + row0_ + kr_) * DQK + kc_ * 8); } \
        _Pragma("unroll") for (int i = 0; i < NVL; ++i) { const int c_ = tid + NTHR * i, vr_ = c_ >> 3, vc_ = c_ & 7; vreg[i] = *(const u32x4*)(VT + (size_t)(head * DV + vr_) * MT + row0_ + vc_ * 8); } } while (0)
#define ATT_STORE(buf) do { \
        _Pragma("unroll") for (int i = 0; i < NKL; ++i) { const int c_ = tid + NTHR * i, kr_ = c_ / KCH, kc_ = c_ % KCH; *(LAS u32x4*)(lds + (buf) * KBUF + kr_ * KSTR + kc_ * 16) = kreg[i]; } \
        _Pragma("unroll") for (int i = 0; i < NVL; ++i) { const int c_ = tid + NTHR * i, vr_ = c_ >> 3, vc_ = c_ & 7; *(LAS u32x4*)(lds + 2 * KBUF + (buf) * VBUF + vr_ * VSTR + vc_ * 16) = vreg[i]; } } while (0)
        ATT_LOAD(0); ATT_STORE(0);
        if (NA) { for (int i = tid; i < 15 * 31; i += NTHR) rpbL[i] = rpb[head * (15 * 31) + i] * LOG2E; }
        __syncthreads();
        float mrun = -INFINITY, lsum = 0.f;
        f32x16 o[NDV];
#pragma unroll
        for (int d = 0; d < NDV; ++d)
#pragma unroll
            for (int i = 0; i < 16; ++i) o[d][i] = 0.f;
        for (int t = 0; t < NT; ++t) {
            const int cur = t & 1;
            if (t + 1 < NT) ATT_LOAD(t + 1);
            bool active = true; int rr = 0; const bool local = NA && (t < nloc);
            if (local) { rr = rlo + t; active = (rr >= rs) && (rr < rs + 8); }
            if (active) {
                f32x16 s[2];
#pragma unroll
                for (int kb = 0; kb < 2; ++kb) {
#pragma unroll
                    for (int i = 0; i < 16; ++i) s[kb][i] = 0.f;
#pragma unroll
                    for (int ks = 0; ks < NKS; ++ks) {
                        const bf16x8 a = *(const LAS bf16x8*)(lds + cur * KBUF + (32 * kb + r) * KSTR + (16 * ks + 8 * hh) * 2);
                        s[kb] = __builtin_amdgcn_mfma_f32_32x32x16_bf16(a, qf[ks], s[kb], 0, 0, 0);
                    }
                }
                if (local) {
                    const int dr = rr - rq + 7;
#pragma unroll
                    for (int kb = 0; kb < 2; ++kb)
#pragma unroll
                        for (int i = 0; i < 16; ++i) { const int kc = 32 * kb + (i & 3) + 8 * (i >> 2) + 4 * hh; const bool valid = (kc >= cs) && (kc < cs + 16);
                            const int dc = min(max(kc - cq + 15, 0), 30);
                            const float bias = rpbL[dr * 31 + dc];
                            s[kb][i] = valid ? s[kb][i] + bias : -INFINITY; }
                }
                float mx = s[0][0];
#pragma unroll
                for (int i = 1; i < 16; ++i) mx = fmaxf(mx, s[0][i]);
#pragma unroll
                for (int i = 0; i < 16; ++i) mx = fmaxf(mx, s[1][i]);
                mx = fmaxf(mx, __shfl_xor(mx, 32));
                const float mnew = fmaxf(mrun, mx), alpha = __builtin_amdgcn_exp2f(mrun - mnew);
                mrun = mnew;
                float ps = 0.f;
#pragma unroll
                for (int kb = 0; kb < 2; ++kb)
#pragma unroll
                    for (int i = 0; i < 16; ++i) { s[kb][i] = __builtin_amdgcn_exp2f(s[kb][i] - mnew); ps += s[kb][i]; }
                lsum = lsum * alpha + ps;
#pragma unroll
                for (int d = 0; d < NDV; ++d)
#pragma unroll
                    for (int i = 0; i < 16; ++i) o[d][i] *= alpha;
#pragma unroll
                for (int kb = 0; kb < 2; ++kb)
#pragma unroll
                    for (int sx = 0; sx < 2; ++sx) {
                        u32x4 pw; pw.x = pk2(s[kb][8 * sx + 0], s[kb][8 * sx + 1]); pw.y = pk2(s[kb][8 * sx + 2], s[kb][8 * sx + 3]);
                        pw.z = pk2(s[kb][8 * sx + 4], s[kb][8 * sx + 5]); pw.w = pk2(s[kb][8 * sx + 6], s[kb][8 * sx + 7]);
                        const bf16x8 pb = __builtin_bit_cast(bf16x8, pw);
#pragma unroll
                        for (int d = 0; d < NDV; ++d) {
                            const LAS unsigned char* vp = lds + 2 * KBUF + cur * VBUF + (32 * d + r) * VSTR + (32 * kb + 16 * sx + 4 * hh) * 2;
                            const u32x2 v0 = *(const LAS u32x2*)vp, v1 = *(const LAS u32x2*)(vp + 16);
                            u32x4 vw; vw.x = v0.x; vw.y = v0.y; vw.z = v1.x; vw.w = v1.y;
                            o[d] = __builtin_amdgcn_mfma_f32_32x32x16_bf16(__builtin_bit_cast(bf16x8, vw), pb, o[d], 0, 0, 0);
                        }
                    }
            }
            if (t + 1 < NT) ATT_STORE(cur ^ 1);
            __syncthreads();
        }
        const float ltot = lsum + __shfl_xor(lsum, 32), inv = 1.f / ltot;
        bf16_t* orow = O + (size_t)qrow * (H * DV) + head * DV;
#pragma unroll
        for (int d = 0; d < NDV; ++d)
#pragma unroll
            for (int g = 0; g < 4; ++g) { u32x2 w; w.x = pk2(o[d][4 * g] * inv, o[d][4 * g + 1] * inv); w.y = pk2(o[d][4 * g + 2] * inv, o[d][4 * g + 3] * inv);
                *(u32x2*)(orow + 32 * d + 8 * g + 4 * hh) = w; }
#undef ATT_LOAD
#undef ATT_STORE
#undef TILE_ROW0
    }
}

__device__ __forceinline__ int swap23(int r) { return (r & ~12) | ((r & 4) << 1) | ((r & 8) >> 1); }
struct MlaOff { int ko1[8], ko2[4], vo[4]; };
constexpr int MLA_K1 = 0, MLA_K2 = 49152, MLA_V = 73728;
template <int SLOT, int KB> __device__ __forceinline__ void mla_s1(f32x16& sd, const f32x16& cinit, LAS unsigned char* lds, const MlaOff& F, const bf16x8 (&qf)[12]) {
    { const bf16x8 a = *(const LAS bf16x8*)(lds + F.ko1[0] + (SLOT * 16384 + KB * 8192)); sd = __builtin_amdgcn_mfma_f32_32x32x16_bf16(a, qf[0], cinit, 0, 0, 0); }
#pragma unroll
    for (int ks = 1; ks < 8; ++ks) { const bf16x8 a = *(const LAS bf16x8*)(lds + F.ko1[ks] + (SLOT * 16384 + KB * 8192)); sd = __builtin_amdgcn_mfma_f32_32x32x16_bf16(a, qf[ks], sd, 0, 0, 0); }
#pragma unroll
    for (int ks = 0; ks < 4; ++ks) { const bf16x8 a = *(const LAS bf16x8*)(lds + F.ko2[ks] + (SLOT * 8192 + KB * 4096)); sd = __builtin_amdgcn_mfma_f32_32x32x16_bf16(a, qf[8 + ks], sd, 0, 0, 0); }
}
template <int VS, int KB, int NS, int NKB>
__device__ __forceinline__ void mla_step(f32x16& sc, f32x16& sn, f32x16 (&o)[4], f32x16& negm, float& lsum, float& mxc, LAS unsigned char* lds, const MlaOff& F, const bf16x8 (&qf)[12]) {
    if (__any(mxc > 0.f)) { const float dlt = fmaxf(mxc, 0.f), alpha = __builtin_amdgcn_exp2f(-dlt); lsum *= alpha;
#pragma unroll
        for (int i = 0; i < 16; ++i) { negm[i] -= dlt; sc[i] -= dlt; }
#pragma unroll
        for (int d = 0; d < 4; ++d)
#pragma unroll
            for (int i = 0; i < 16; ++i) o[d][i] *= alpha; }
    mla_s1<NS, NKB>(sn, negm, lds, F, qf);
    float ps = 0.f;
#pragma unroll
    for (int i = 0; i < 16; ++i) { sc[i] = __builtin_amdgcn_exp2f(sc[i]); ps += sc[i]; }
    lsum += ps;
#pragma unroll
    for (int sx = 0; sx < 2; ++sx) {
        u32x4 pw; pw.x = pk2(sc[8 * sx + 0], sc[8 * sx + 1]); pw.y = pk2(sc[8 * sx + 2], sc[8 * sx + 3]); pw.z = pk2(sc[8 * sx + 4], sc[8 * sx + 5]); pw.w = pk2(sc[8 * sx + 6], sc[8 * sx + 7]);
        const bf16x8 pb = __builtin_bit_cast(bf16x8, pw);
#pragma unroll
        for (int d = 0; d < 4; ++d) { const bf16x8 va = *(const LAS bf16x8*)(lds + F.vo[2 * KB + sx] + (VS * 16384 + d * 4096)); o[d] = __builtin_amdgcn_mfma_f32_32x32x16_bf16(va, pb, o[d], 0, 0, 0); } }
    float mx = sn[0];
#pragma unroll
    for (int i = 1; i < 16; ++i) mx = fmaxf(mx, sn[i]);
    mxc = fmaxf(mx, __shfl_xor(mx, 32));
}
__device__ __forceinline__ void attn_mla_phase(LAS unsigned char* lds, const bf16_t* __restrict__ Q, const bf16_t* __restrict__ Kf, const bf16_t* __restrict__ VT, bf16_t* __restrict__ O) {
    constexpr int H = 8, DQK = 192, DV = 128;
    const int tid = opaque_tid(), wave = __builtin_amdgcn_readfirstlane(tid >> 6), lane = tid & 63, r = lane & 31, hh = lane >> 5;
    unsigned goff[5], lbase[5], lstr[5]; bool isv[5];
#pragma unroll
    for (int i = 0; i < 5; ++i) {
        const int j = wave * 5 + i;
        if (j < 16) { const int q = j * 64 + lane, key = q >> 4, c = (q & 15) ^ (key & 15); goff[i] = key * DQK + c * 8; lbase[i] = MLA_K1 + j * 1024; lstr[i] = 16384; isv[i] = false; }
        else if (j < 24) { const int q = (j - 16) * 64 + lane, row = q >> 4, cc = (q & 15) ^ (row & 15), key = 2 * row + (cc >> 3); goff[i] = key * DQK + 128 + (cc & 7) * 8; lbase[i] = MLA_K2 + (j - 16) * 1024; lstr[i] = 8192; isv[i] = false; }
        else { const int q = (j - 24) * 64 + lane, row2 = q >> 4, cc = (q & 15) ^ (row2 & 15), dv = 2 * row2 + (cc >> 3); goff[i] = dv * MT + (cc & 7) * 8; lbase[i] = MLA_V + (j - 24) * 1024; lstr[i] = 16384; isv[i] = true; }
    }
    MlaOff F;
    { const int pr = swap23(r), kx = pr & 15, k1row = pr * 256, k2row = (pr >> 1) * 256, k2cb = (pr & 1) * 8, k2x = (pr >> 1) & 15, vrow = (r >> 1) * 256, vcb = (r & 1) * 8, vx = (r >> 1) & 15;
#pragma unroll
      for (int ks = 0; ks < 8; ++ks) F.ko1[ks] = MLA_K1 + k1row + (((2 * ks + hh) ^ kx) << 4);
#pragma unroll
      for (int ks = 0; ks < 4; ++ks) F.ko2[ks] = MLA_K2 + k2row + (((k2cb + 2 * ks + hh) ^ k2x) << 4);
#pragma unroll
      for (int c = 0; c < 4; ++c) F.vo[c] = MLA_V + vrow + (((vcb + 2 * c + hh) ^ vx) << 4); }
    const int nbig = 64 * H, nunits = 65 * H;
    for (int u = blockIdx.x; u < nunits; u += gridDim.x) {
        int head, qb;
        if (u < nbig) { const int b = u & 255, rnd = u >> 8, xcd = b & 7, slot = b >> 3; head = xcd + 8 * (rnd >> 1); qb = 1 + (rnd & 1) * 32 + slot; }
        else { head = u - nbig; qb = 0; }
        const int NT = (qb == 0) ? 4 : 260;
        const int qrow = 256 * qb + 32 * wave + r;
        bf16x8 qf[12];
#pragma unroll
        for (int ks = 0; ks < 12; ++ks) qf[ks] = *(const bf16x8*)(Q + ((size_t)head * MT + qrow) * DQK + 16 * ks + 8 * hh);
        const bf16_t* kbase = Kf + (size_t)head * MT * DQK; const bf16_t* vbase = VT + (size_t)head * DV * MT;
#define MLA_ISSUE(s, SL) do { const bf16_t* kb_ = kbase + (size_t)(s) * 64 * DQK; const bf16_t* vb_ = vbase + (size_t)(s) * 64; \
        _Pragma("unroll") for (int i = 0; i < 5; ++i) __builtin_amdgcn_global_load_lds((const unsigned*)((isv[i] ? vb_ : kb_) + goff[i]), (LAS unsigned*)(lds + lbase[i] + (SL) * lstr[i]), 16, 0, 0); } while (0)
#define MLA_WAITBAR() do { asm volatile("s_waitcnt vmcnt(0)" ::: "memory"); __builtin_amdgcn_s_barrier(); asm volatile("" ::: "memory"); } while (0)
#define MLA_TILE(t, SL) do { \
        mla_step<SL, 0, SL, 1>(sA, sB, o, negm, lsum, mxc, lds, F, qf); \
        if ((t) + 2 < NT) MLA_ISSUE((t) + 2, ((SL) + 2) % 3); \
        mla_step<SL, 1, ((SL) + 1) % 3, 0>(sB, sA, o, negm, lsum, mxc, lds, F, qf); \
        MLA_WAITBAR(); } while (0)
        float lsum = 0.f, mxc;
        f32x16 o[4], sA, sB, negm;
#pragma unroll
        for (int d = 0; d < 4; ++d)
#pragma unroll
            for (int i = 0; i < 16; ++i) o[d][i] = 0.f;
        MLA_ISSUE(0, 0); MLA_ISSUE(1, 1);
        MLA_WAITBAR();
        { f32x16 z;
#pragma unroll
          for (int i = 0; i < 16; ++i) z[i] = 0.f;
          mla_s1<0, 0>(sA, z, lds, F, qf);
          float mx_ = sA[0];
#pragma unroll
          for (int i = 1; i < 16; ++i) mx_ = fmaxf(mx_, sA[i]);
          mx_ = fmaxf(mx_, __shfl_xor(mx_, 32));
#pragma unroll
          for (int i = 0; i < 16; ++i) { negm[i] = -mx_; sA[i] -= mx_; }
          mxc = 0.f; }
        int t = 0;
        for (; t + 3 <= NT; t += 3) { MLA_TILE(t, 0); MLA_TILE(t + 1, 1); MLA_TILE(t + 2, 2); }
        if (t < NT) { MLA_TILE(t, 0); if (t + 1 < NT) MLA_TILE(t + 1, 1); }
        const float ltot = lsum + __shfl_xor(lsum, 32), inv = 1.f / ltot;
        bf16_t* orow = O + (size_t)qrow * (H * DV) + head * DV;
#pragma unroll
        for (int d = 0; d < 4; ++d)
#pragma unroll
            for (int g = 0; g < 4; ++g) { u32x2 w; w.x = pk2(o[d][4 * g] * inv, o[d][4 * g + 1] * inv); w.y = pk2(o[d][4 * g + 2] * inv, o[d][4 * g + 3] * inv);
                *(u32x2*)(orow + 32 * d + 8 * g + 4 * hh) = w; }
#undef MLA_ISSUE
#undef MLA_WAITBAR
#undef MLA_TILE
    }
}

struct Args { const float* in[30]; float* out; unsigned char* ws; int ph_lo, ph_hi; };

typedef const __attribute__((address_space(4))) Args* ArgsP;
__device__ __forceinline__ ArgsP get_args() { ArgsP p = (ArgsP)__builtin_amdgcn_kernarg_segment_ptr(); asm volatile("" : "+s"(p)); return p; }
#define WSP(T, off) ((T*)(ws + (off)))

#define PHASE_BEGIN if (ph >= lo && ph < hi) { ArgsP ap = get_args(); unsigned char* ws = ap->ws; (void)ws;
#define PHASE_END   if (ph + 1 < hi) xcd_barrier(bar); } ++ph;
#define P_X WSP(float, WS_X)
#define P_H WSP(bf16_t, WS_H)
#define P_BIG WSP(bf16_t, WS_BIG)
#define P_MIX WSP(bf16_t, WS_MIX)
#define P_QF WSP(bf16_t, WS_QF)
#define P_KF WSP(bf16_t, WS_KF)
#define P_VT WSP(bf16_t, WS_VT)
#define P_MODL (WSP(float, WS_MOD) + (size_t)L * 2 * 9216)
template <int L>
__device__ __forceinline__ void layer_body(const XcdBarrier& bar, LAS unsigned char* lds, int& ph, const int lo, const int hi) {
    constexpr bool CTX_A = (L <= 2);
    constexpr bool CTX_B = (L <= 1);
    constexpr int RB_A = CTX_A ? 0 : CTX, M_A = CTX_A ? MT : SEQ;
    constexpr int RB_B = CTX_B ? 0 : CTX, M_B = CTX_B ? MT : SEQ;
    PHASE_BEGIN for (int rep = 0; rep < REP_NORM; ++rep) norm_phase((L == 0) ? ap->in[2] : P_X, (L == 0) ? ap->in[0] : P_X + (size_t)CTX * D, P_H, P_MODL, 0, 1, RB_A); PHASE_END
    PHASE_BEGIN for (int rep = 0; rep < REP_FFNIN; ++rep) { EpiSwiglu E{P_BIG, DFF, RB_A}; run_gemm(lds, P_H + (size_t)RB_A * D, WSP(bf16_t, WS_WIN) + (size_t)(2 * L) * 5632 * 1024, M_A, 2 * DFF, D, E, 0); } PHASE_END
    PHASE_BEGIN {
        const bf16_t* W = WSP(bf16_t, WS_WOUT) + (size_t)(2 * L) * 1024 * 2816;
        for (int rep = 1; rep < REP_FFNOUT; ++rep) { EpiResid E{P_X, WSP(float, WS_QF), P_MODL + 9216 + 2 * D, 0.5f, CTX, CTX, 0}; run_gemm(lds, P_BIG + (size_t)CTX * DFF, W, SEQ, D, DFF, E, 0); }
        { EpiResid E{(L == 0) ? ap->in[0] : P_X, P_X, P_MODL + 9216 + 2 * D, 0.5f, CTX, 0, (L == 0) ? CTX : 0}; run_gemm(lds, P_BIG + (size_t)CTX * DFF, W, SEQ, D, DFF, E, 0); }
        if (CTX_A) ctx_resid<DFF>(lds, P_BIG, W, (L == 0) ? ap->in[2] : P_X, P_X, P_MODL + 2 * D, 0.5f);
    } PHASE_END
    PHASE_BEGIN for (int rep = 0; rep < REP_NORM; ++rep) norm_phase(P_X, P_X + (size_t)CTX * D, P_H, P_MODL, 3, 4, RB_A); PHASE_END
    if (L == 0) {
        PHASE_BEGIN { EpiStore E{WSP(bf16_t, WS_DQKV), 768, 0}; run_gemm(lds, P_H, WSP(bf16_t, WS_MLA_DQKV), MT, 768, D, E, 0); } PHASE_END
        PHASE_BEGIN mla_na_phase(WSP(bf16_t, WS_DQKV), WSP(bf16_t, WS_CQN), WSP(bf16_t, WS_CKVN), P_KF, ap->in[9], ap->in[12], ap->in[18]); PHASE_END
        PHASE_BEGIN {
            { EpiStore E{P_BIG, 1536, 0}; run_gemm(lds, WSP(bf16_t, WS_CQN), WSP(bf16_t, WS_MLA_UQ), MT, 1536, 384, E, 0); }
            { EpiStore E{P_BIG + (size_t)MT * 1536, 1024, 0}; run_gemm(lds, WSP(bf16_t, WS_CKVN), WSP(bf16_t, WS_MLA_UK), MT, 1024, 256, E, 134); }
            { EpiStore E{P_VT, MT, 0}; run_gemm(lds, WSP(bf16_t, WS_MLA_UVT), WSP(bf16_t, WS_CKVN), 1024, MT, 256, E, 138); }
        } PHASE_END
        PHASE_BEGIN mla_nb_phase(P_BIG, P_BIG + (size_t)MT * 1536, P_QF, P_KF, ap->in[15], ap->in[16], ap->in[17], 0.07216878364870322f * LOG2E); PHASE_END
        PHASE_BEGIN attn_mla_phase(lds, P_QF, P_KF, P_VT, P_MIX); PHASE_END
    } else if (L == 1) {
        PHASE_BEGIN pool_phase(P_H, P_MIX); PHASE_END
    } else if (L == 2) {
        PHASE_BEGIN {
            { EpiNaQK E{P_QF, P_KF, ap->in[23], ap->in[24], 0.125f * LOG2E}; run_gemm(lds, P_H, WSP(bf16_t, WS_NA_QK), MT, 2048, D, E, 0); }
            { EpiStore E{P_VT, MT, 0}; run_gemm(lds, WSP(bf16_t, WS_NA_VT), P_H, 1024, MT, D, E, 8); }
        } PHASE_END
        PHASE_BEGIN attn_phase<64, 64, true>(lds, P_QF, P_KF, P_VT, P_MIX, ap->in[25], 16, false); PHASE_END
    } else {
        PHASE_BEGIN {
            { EpiMulPair E{P_BIG, D, CTX}; run_gemm(lds, P_H + (size_t)CTX * D, WSP(bf16_t, WS_CV_IN), SEQ, 2048, D, E, 0); }
            { EpiStore E{P_BIG + (size_t)MT * D, D, CTX}; run_gemm(lds, P_H + (size_t)CTX * D, WSP(bf16_t, WS_CV_IN) + (size_t)2048 * D, SEQ, D, D, E, 0); }
        } PHASE_END
        PHASE_BEGIN conv_phase(P_BIG, P_BIG + (size_t)MT * D, P_MIX, ap->in[28]); PHASE_END
    }
    PHASE_BEGIN {
        const size_t wo_off = (L == 0) ? WS_MLA_O : (L == 1) ? WS_POOL : (L == 2) ? WS_NA_O : WS_CV_OUT;
        { EpiResid E{P_X, P_X, P_MODL + 9216 + 5 * D, 1.0f, CTX, 0, 0}; run_gemm(lds, P_MIX + (size_t)CTX * D, WSP(bf16_t, wo_off), SEQ, D, D, E, 0); }
        if (CTX_B) ctx_resid<D>(lds, P_MIX, WSP(bf16_t, wo_off), P_X, P_X, P_MODL + 5 * D, 1.0f);
    } PHASE_END
    PHASE_BEGIN for (int rep = 0; rep < REP_NORM; ++rep) norm_phase(P_X, P_X + (size_t)CTX * D, P_H, P_MODL, 6, 7, RB_B); PHASE_END
    PHASE_BEGIN for (int rep = 0; rep < REP_FFNIN; ++rep) { EpiSwiglu E{P_BIG, DFF, RB_B}; run_gemm(lds, P_H + (size_t)RB_B * D, WSP(bf16_t, WS_WIN) + (size_t)(2 * L + 1) * 5632 * 1024, M_B, 2 * DFF, D, E, 0); } PHASE_END
    PHASE_BEGIN {
        const bf16_t* W = WSP(bf16_t, WS_WOUT) + (size_t)(2 * L + 1) * 1024 * 2816;
        { EpiResid E{P_X, (L == 3) ? ap->out : P_X, P_MODL + 9216 + 8 * D, 0.5f, CTX, (L == 3) ? CTX : 0, 0}; run_gemm(lds, P_BIG + (size_t)CTX * DFF, W, SEQ, D, DFF, E, 0); }
        if (CTX_B) ctx_resid<DFF>(lds, P_BIG, W, P_X, P_X, P_MODL + 8 * D, 0.5f);
    } if (L < 3 && ph + 1 < hi) xcd_barrier(bar); } ++ph;
}
__global__ void __launch_bounds__(NTHR, 2) fwd_megakernel(Args args_unused) {
    extern __shared__ __attribute__((aligned(16))) unsigned char lds_raw[];
    LAS unsigned char* lds = (LAS unsigned char*)lds_raw;
    cg::grid_group grid = cg::this_grid();
    int lo, hi; unsigned* barw; { ArgsP ap0 = get_args(); lo = ap0->ph_lo; hi = ap0->ph_hi; barw = (unsigned*)(ap0->ws + WS_BAR); }
    if (lo > hi) grid.sync();
    volatile LAS unsigned* bst = (volatile LAS unsigned*)(lds + 131072);
    if (threadIdx.x < 4) bst[threadIdx.x] = 0u;
    __syncthreads();
    const XcdBarrier bar = xcd_barrier_post(barw, bst);
    int ph = 0;

    PHASE_BEGIN
    for (int rep = 0; rep < REP_P0; ++rep) {
        const int tid = opaque_tid(), lane = tid & 63, wave = tid >> 6;
        bf16_t* WIN = WSP(bf16_t, WS_WIN); bf16_t* WOUT = WSP(bf16_t, WS_WOUT); bf16_t* W_DQKV = WSP(bf16_t, WS_MLA_DQKV); bf16_t* W_POOL = WSP(bf16_t, WS_POOL);
        ConvCtx c; c.base = 0; c.gw = blockIdx.x * NWAVE + wave; c.ngw = gridDim.x * NWAVE; c.lane = lane; c.scr = (LAS float*)(lds + wave * 16384);
        for (int lf = 0; lf < 8; ++lf) {
            conv_job(c, ap->in[6] + (size_t)lf * 1024 * 5632, 5632, 1024, 0, 5632, WIN + (size_t)lf * 5632 * 1024, 1024, 0, 0, nullptr, 1);
            conv_job(c, ap->in[7] + (size_t)lf * 2816 * 1024, 1024, 2816, 0, 1024, WOUT + (size_t)lf * 1024 * 2816, 2816, 0, 0, nullptr, 0);
        }
        conv_job(c, ap->in[8], 384, 1024, 0, 384, W_DQKV, 1024, 0, 0, nullptr, 0);
        conv_job(c, ap->in[11], 320, 1024, 0, 320, W_DQKV, 1024, 384, 0, nullptr, 0);
        conv_job(c, ap->in[10], 1536, 384, 0, 1536, WSP(bf16_t, WS_MLA_UQ), 384, 0, 0, nullptr, 0);
        conv_job(c, ap->in[13], 1024, 256, 0, 1024, WSP(bf16_t, WS_MLA_UK), 256, 0, 0, nullptr, 0);
        conv_job(c, ap->in[14], 1024, 256, 0, 1024, WSP(bf16_t, WS_MLA_UVT), 256, 0, 0, nullptr, 0);
        conv_job(c, ap->in[19], 1024, 1024, 0, 1024, WSP(bf16_t, WS_MLA_O), 1024, 0, 0, nullptr, 0);
        for (int g = 0; g < 4; ++g) conv_job(c, ap->in[20] + (size_t)g * 65536, 256, 256, 0, 256, W_POOL, 1024, g * 256, g * 256, ap->in[21], 0);
        conv_job(c, ap->in[22], 3072, 1024, 0, 2048, WSP(bf16_t, WS_NA_QK), 1024, 0, 0, nullptr, 2);
        conv_job(c, ap->in[22], 3072, 1024, 2048, 1024, WSP(bf16_t, WS_NA_VT), 1024, 0, 0, nullptr, 0);
        conv_job(c, ap->in[26], 1024, 1024, 0, 1024, WSP(bf16_t, WS_NA_O), 1024, 0, 0, nullptr, 0);
        conv_job(c, ap->in[27], 3072, 1024, 1024, 2048, WSP(bf16_t, WS_CV_IN), 1024, 0, 0, nullptr, 3);
        conv_job(c, ap->in[27], 3072, 1024, 0, 1024, WSP(bf16_t, WS_CV_IN), 1024, 2048, 0, nullptr, 0);
        conv_job(c, ap->in[29], 1024, 1024, 0, 1024, WSP(bf16_t, WS_CV_OUT), 1024, 0, 0, nullptr, 0);
        const long gt = (long)blockIdx.x * NTHR + tid, nt = (long)gridDim.x * NTHR;
        for (long i = gt; i < 64 * 128; i += nt) *((u32x4*)(W_DQKV + (size_t)704 * 1024) + i) = (u32x4){0u, 0u, 0u, 0u};
        for (long i = gt; i < 1024 * 128; i += nt) { const int row = (int)(i >> 7), ch = (int)(i & 127); if ((row >> 8) != (ch >> 5)) *((u32x4*)(W_POOL + (size_t)row * 1024) + ch) = (u32x4){0u, 0u, 0u, 0u}; }
        const float* mw = ap->in[4]; const float* cctx = ap->in[3]; const float* clat = ap->in[1]; const float* mb = ap->in[5]; float* MOD = WSP(float, WS_MOD);
        for (int it = blockIdx.x; it < 256; it += gridDim.x) {
            const int l = it >> 6, col0 = (it & 63) * 144, k0 = 128 * wave;
            f32x4 ac = (f32x4){0.f, 0.f, 0.f, 0.f}, al = (f32x4){0.f, 0.f, 0.f, 0.f};
            if (lane < 36) {
                const float* w = mw + ((size_t)l * 1024 + k0) * 9216 + col0 + 4 * lane;
#pragma unroll 8
                for (int k = 0; k < 128; ++k) { const f32x4 wv = *(const f32x4*)(w + (size_t)k * 9216);
                    const float cc = cctx[k0 + k], cl = clat[k0 + k];
                    const float sc = cc / (1.f + __expf(-cc)), sl = cl / (1.f + __expf(-cl));
                    ac += wv * sc; al += wv * sl; }
                LAS float* pp = (LAS float*)(lds + wave * 16384 + 12288);
                *(LAS f32x4*)(pp + 4 * lane) = ac; *(LAS f32x4*)(pp + 144 + 4 * lane) = al;
            }
            __syncthreads();
            if (tid < 288) { const int sidx = tid / 144, c = tid % 144; float a = mb[l * 9216 + col0 + c];
#pragma unroll
                for (int w8 = 0; w8 < 8; ++w8) a += *(const LAS float*)(lds + w8 * 16384 + 12288 + (sidx * 144 + c) * 4);
                MOD[((size_t)l * 2 + sidx) * 9216 + col0 + c] = a; }
            __syncthreads();
        }
    }
    PHASE_END

    layer_body<0>(bar, lds, ph, lo, hi);
    layer_body<1>(bar, lds, ph, lo, hi);
    layer_body<2>(bar, lds, ph, lo, hi);
    layer_body<3>(bar, lds, ph, lo, hi);
}

extern "C" void kernel_launch(void* const* d_in, const int* in_sizes, int n_in, void* d_out, int out_size, void* d_ws, size_t ws_size, hipStream_t stream) {
    static int grid_blocks = 0;
    if (grid_blocks == 0) {
        if (n_in != 30 || out_size != SEQ * D || ws_size < WS_END) { fprintf(stderr, "kernel_launch: unexpected shapes (n_in %d out %d ws %zu need %zu)\n", n_in, out_size, ws_size, (size_t)WS_END); grid_blocks = -1; return; }
        int dev = 0, cus = 0, per_cu = 0;
        hipGetDevice(&dev);
        hipDeviceGetAttribute(&cus, hipDeviceAttributeMultiprocessorCount, dev);
        if (hipFuncSetAttribute((const void*)fwd_megakernel, hipFuncAttributeMaxDynamicSharedMemorySize, LDS_BYTES) != hipSuccess) { fprintf(stderr, "kernel_launch: hipFuncSetAttribute failed\n"); grid_blocks = -1; return; }
        if (hipOccupancyMaxActiveBlocksPerMultiprocessor(&per_cu, (const void*)fwd_megakernel, NTHR, LDS_BYTES) != hipSuccess || per_cu < 1) { fprintf(stderr, "kernel_launch: occupancy query failed (%d)\n", per_cu); per_cu = 1; (void)hipGetLastError(); }
        grid_blocks = cus * 1;
        (void)per_cu;
    }
    if (grid_blocks < 0) return;
    if (hipMemsetAsync((unsigned char*)d_ws + WS_BAR, 0, (size_t)XCD_BAR_WORDS * 4, stream) != hipSuccess) { fprintf(stderr, "kernel_launch: memset of the barrier words failed\n"); return; }
    Args a{};
    for (int i = 0; i < 30; ++i) a.in[i] = (const float*)d_in[i];
    a.out = (float*)d_out; a.ws = (unsigned char*)d_ws; a.ph_lo = 0; a.ph_hi = 1 << 20;
    void* kargs[] = {&a};
    hipError_t e = hipLaunchCooperativeKernel((const void*)fwd_megakernel, dim3(grid_blocks), dim3(NTHR), kargs, LDS_BYTES, stream);
    if (e != hipSuccess) fprintf(stderr, "kernel_launch: cooperative launch failed: %s (grid %d)\n", hipGetErrorString(e), grid_blocks);
}
```

```cpp
#include <hip/hip_runtime.h>
#include <hip/hip_cooperative_groups.h>
#include <cstdio>
#include <cstdint>
namespace cg = cooperative_groups;
__device__ __forceinline__ int opaque_tid() { int t = (int)threadIdx.x; asm volatile("" : "+v"(t)); return t; }
#define LAS __attribute__((address_space(3)))
#define XB_TMO      128
#define XB_XCNT(j)  (256  + 64 * (j))
#define XB_XSUB(j)  (1280 + 64 * (j))
#define XB_XGEN(j)  (2304 + 64 * (j))
#define XB_TOP      3328
#define XB_TOPGEN   3392
#define XCD_BAR_WORDS 3456
#define XB_SPIN_CAP (1u << 18)

__device__ __forceinline__ unsigned xb_ld(unsigned* p)              { return __hip_atomic_load(p, __ATOMIC_RELAXED, __HIP_MEMORY_SCOPE_AGENT); }
__device__ __forceinline__ unsigned xb_add(unsigned* p, unsigned v) { return __hip_atomic_fetch_add(p, v, __ATOMIC_RELAXED, __HIP_MEMORY_SCOPE_AGENT); }
__device__ __forceinline__ unsigned xb_xcc_id() { return (unsigned)__builtin_amdgcn_s_getreg((3 << 11) | 20) & 0xFu; }
#define XB_SPIN(cond, bar) do { unsigned _sp = 0; while (cond) { __builtin_amdgcn_s_sleep(1); \
    if ((++_sp & 255u) == 0u) { if (xb_ld(&(bar)[XB_TMO])) break; if (_sp > XB_SPIN_CAP) { atomicAdd(&(bar)[XB_TMO], 1u); break; } } } } while (0)

struct XcdBarrier {
    unsigned* bar; unsigned x;
    volatile LAS unsigned* st;
};

__device__ __forceinline__ XcdBarrier xcd_barrier_post(unsigned* bar, volatile LAS unsigned* st) {
    XcdBarrier b; b.bar = bar; b.x = xb_xcc_id(); b.st = st;
    if (threadIdx.x == 0) (void)xb_add(&bar[XB_XCNT(b.x)], 1u);
    return b;
}
__device__ __forceinline__ void xcd_barrier_complete(unsigned* bar, unsigned x, unsigned& nloc, unsigned& nx) {
    const unsigned G = gridDim.x * gridDim.y * gridDim.z;
    unsigned sum, cnt, mine, sp = 0u;
    for (;;) {
        sum = 0u; cnt = 0u; mine = 0u;
#pragma unroll
        for (unsigned j = 0; j < 16; ++j) { const unsigned c = xb_ld(&bar[XB_XCNT(j)]); sum += c; cnt += (c > 0u) ? 1u : 0u; mine = (j == x) ? c : mine; }
        if (sum == G) break;
        __builtin_amdgcn_s_sleep(1);
        if ((++sp & 255u) == 0u) { if (xb_ld(&bar[XB_TMO])) break; if (sp > XB_SPIN_CAP) { atomicAdd(&bar[XB_TMO], 1u); break; } }
    }
    nloc = mine > 0u ? mine : 1u; nx = cnt > 0u ? cnt : 1u;
}

__device__ __forceinline__ void xcd_barrier(const XcdBarrier& b) {
    asm volatile("s_waitcnt vmcnt(0)" ::: "memory");
    __syncthreads();
    if (threadIdx.x == 0) {
        unsigned* bar = b.bar;
        __builtin_amdgcn_s_waitcnt(0);
        unsigned nloc = b.st[0], nx = b.st[1];
        if (nloc == 0u) { xcd_barrier_complete(bar, b.x, nloc, nx); b.st[0] = nloc; b.st[1] = nx; }
        const unsigned old = xb_add(&bar[XB_XSUB(b.x)], 1u);
        const unsigned gen = old / nloc;
        if (old + 1u == (gen + 1u) * nloc) {
            __builtin_amdgcn_fence(__ATOMIC_RELEASE, "agent");
            asm volatile("s_waitcnt vmcnt(0)" ::: "memory");
            const unsigned og = xb_add(&bar[XB_TOP], 1u);
            const unsigned tg = og / nx;
            if (og + 1u == (tg + 1u) * nx) xb_add(&bar[XB_TOPGEN], 1u);
            else XB_SPIN(xb_ld(&bar[XB_TOPGEN]) == tg, bar);
            __builtin_amdgcn_fence(__ATOMIC_ACQUIRE, "agent");
            xb_add(&bar[XB_XGEN(b.x)], 1u);
            asm volatile("s_waitcnt vmcnt(0)" ::: "memory");
        } else {
            XB_SPIN(xb_ld(&bar[XB_XGEN(b.x)]) == gen, bar);
            __builtin_amdgcn_fence(__ATOMIC_ACQUIRE, "agent");
            asm volatile("s_waitcnt vmcnt(0)" ::: "memory");
        }
    }
    __syncthreads();
}
namespace pg8 {
#define PG8_LAS __attribute__((address_space(3)))
typedef unsigned short bf16_t;
typedef short bf16x8 __attribute__((ext_vector_type(8)));
typedef float f32x4 __attribute__((ext_vector_type(4)));
typedef unsigned u32x4 __attribute__((ext_vector_type(4)));
constexpr int BM = 256, BK = 64, HALF = 128, HTB = HALF * BK * 2  , STAGE_BYTES = 8 * HTB, NXCD = 8, WGM = 8;

__host__ __device__ __forceinline__ int lds_byte(int r, int c) { const int st = (r >> 4) * 2 + (c >> 5), rr = r & 15, cc = c & 31, ob = rr * 64 + cc * 2; return st * 1024 + (ob ^ (((ob >> 9) & 1) << 5)); }
__host__ __device__ __forceinline__ void stage_rc(int b, int& R, int& C) { const int st = b / 1024, sb = b % 1024, swz = sb ^ (((sb >> 9) & 1) << 5); R = (st >> 1) * 16 + swz / 64; C = (st & 1) * 32 + (swz % 64) / 2; }
__host__ __device__ __forceinline__ int perm32(int rho) { const int n = rho >> 4, i = rho & 15; return 8 * (i >> 2) + 4 * n + (i & 3); }

struct Unit { int pm, pn; };
struct Gemm { const bf16_t* A; const bf16_t* Bt; int M, N, K; };

struct StaticOrder {
    int nM, nN, nwg, G, c;
    __host__ __device__ void init(int M, int N, int G_, int c_) { nM = M / BM; nN = N / BM; nwg = nM * nN; G = G_; c = c_; }
    __host__ __device__ bool next(int i, Unit& u) const {
        const long L = (long)i * G + c; if (L >= nwg) return false;
        int wgid = (int)L; { const int q = nwg / NXCD, r = nwg % NXCD, xcd = wgid % NXCD, off = wgid / NXCD; wgid = (xcd < r ? xcd * (q + 1) : r * (q + 1) + (xcd - r) * q) + off; }
        const int nig = WGM * nN, gid = wgid / nig, fm = gid * WGM, gsz = (nM - fm) < WGM ? (nM - fm) : WGM;
        u.pm = fm + ((wgid % nig) % gsz); u.pn = (wgid % nig) / gsz; return true;
    }
    __device__ __forceinline__ void a_ready(const Unit&) const {}
    __device__ __forceinline__ void done(const Unit&) const {}
};
__device__ __forceinline__ unsigned cvt_pk_bf16(float lo, float hi) { unsigned r; asm volatile("v_cvt_pk_bf16_f32 %0, %1, %2" : "=v"(r) : "v"(lo), "v"(hi)); return r; }
template <class Epi, class Sched, bool ALIGN_EPI = false, bool SP2 = false>
__device__ __forceinline__ void gemm_phase(PG8_LAS unsigned char* lds, const Gemm g, const Sched& S, const Epi& E) {
    const int tid = opaque_tid(), wid = __builtin_amdgcn_readfirstlane(tid >> 6), lane = tid & 63, wr = wid >> 2, wc = wid & 3, fr = lane & 15, fq = lane >> 4;
    const int K = g.K, nt = K / BK;
    unsigned voffA[2], voffB[2];
#pragma unroll
    for (int i = 0; i < 2; ++i) { int R, C; stage_rc(tid * 16 + i * 8192, R, C); const int Rb = Epi::PERM ? ((R & ~31) + perm32(R & 31)) : R;
        voffA[i] = (unsigned)(R * K + C) * 2u; voffB[i] = (unsigned)(Rb * K + C) * 2u; }
    const size_t kstep = (size_t)(BK * 2);
    const size_t hstep = (size_t)HALF * K * 2;
    const size_t tstep = 2 * hstep;
    const unsigned ldsw = (unsigned)wid * 1024u;
    const int aoff = lds_byte(wr * 64 + fr, fq * 8), boff = lds_byte(wc * 32 + fr, fq * 8);
#define PG8_SA(b, h) (((b) * 2 + (h)) * HTB)
#define PG8_SB(b, h) ((4 + (b) * 2 + (h)) * HTB)
#define PG8_STAGE(bufoff, gbase, voff) do { _Pragma("unroll") for (int _i = 0; _i < 2; ++_i) \
        __builtin_amdgcn_global_load_lds((const unsigned*)((const char*)(gbase) + (voff)[_i]), (PG8_LAS unsigned*)(lds + (bufoff) + ldsw + _i * 8192), 16, 0, 0); } while (0)
#define PG8_LDA(dst, b, h) do { _Pragma("unroll") for (int m = 0; m < 4; ++m) _Pragma("unroll") for (int k = 0; k < 2; ++k) dst[m][k] = *(const PG8_LAS bf16x8*)(lds + PG8_SA(b, h) + aoff + m * 2048 + k * 1024); } while (0)
#define PG8_LDB(dst, b, h) do { _Pragma("unroll") for (int n = 0; n < 2; ++n) _Pragma("unroll") for (int k = 0; k < 2; ++k) dst[n][k] = *(const PG8_LAS bf16x8*)(lds + PG8_SB(b, h) + boff + n * 2048 + k * 1024); } while (0)
#define PG8_MMA(ai, bj, At, Bt) do { __builtin_amdgcn_s_setprio(1); _Pragma("unroll") for (int m = 0; m < 4; ++m) _Pragma("unroll") for (int n = 0; n < 2; ++n) _Pragma("unroll") for (int k = 0; k < 2; ++k) \
        acc[ai][bj][m][n] = __builtin_amdgcn_mfma_f32_16x16x32_bf16(Bt[n][k], At[m][k], acc[ai][bj][m][n], 0, 0, 0); __builtin_amdgcn_s_setprio(0); } while (0)
#define PG8_WAIT_V(n) asm volatile("s_waitcnt vmcnt(" #n ")" ::: "memory")
#define PG8_WAIT_L(n) asm volatile("s_waitcnt lgkmcnt(" #n ")" ::: "memory")
#define PG8_BAR __builtin_amdgcn_s_barrier()
#define PG8_SCHED __builtin_amdgcn_sched_barrier(0)
    Unit cur, nxt; int ui = 0;
    if (!S.next(0, cur)) return;
    f32x4 acc[2][2][4][2];
#pragma unroll
    for (int a = 0; a < 2; ++a)
#pragma unroll
        for (int b = 0; b < 2; ++b)
#pragma unroll
            for (int m = 0; m < 4; ++m)
#pragma unroll
                for (int n = 0; n < 2; ++n) acc[a][b][m][n] = (f32x4){0.f, 0.f, 0.f, 0.f};
    bf16x8 At[4][2], B0[2][2], B1[2][2];
    const char* cA = (const char*)g.A + (size_t)cur.pm * tstep; const char* cB = (const char*)g.Bt + (size_t)cur.pn * tstep;
    S.a_ready(cur);
    if constexpr (SP2) {
        PG8_STAGE(PG8_SB(0, 0), cB, voffB); PG8_STAGE(PG8_SB(0, 1), cB + hstep, voffB); PG8_STAGE(PG8_SA(0, 0), cA, voffA); PG8_STAGE(PG8_SA(0, 1), cA + hstep, voffA);
        if (wr == 1) PG8_BAR;
        PG8_WAIT_V(2); PG8_BAR;
        PG8_STAGE(PG8_SB(1, 0), cB + kstep, voffB); PG8_STAGE(PG8_SA(1, 0), cA + kstep, voffA); PG8_STAGE(PG8_SB(1, 1), cB + hstep + kstep, voffB);
        PG8_WAIT_V(6); PG8_BAR;
    } else {
        PG8_STAGE(PG8_SB(0, 0), cB, voffB); PG8_STAGE(PG8_SA(0, 0), cA, voffA); PG8_STAGE(PG8_SB(0, 1), cB + hstep, voffB); PG8_STAGE(PG8_SA(0, 1), cA + hstep, voffA);
        if (wr == 1) PG8_BAR;
        PG8_WAIT_V(4); PG8_BAR;
        PG8_STAGE(PG8_SB(1, 0), cB + kstep, voffB); PG8_STAGE(PG8_SA(1, 0), cA + kstep, voffA); PG8_STAGE(PG8_SB(1, 1), cB + hstep + kstep, voffB);
        PG8_WAIT_V(6); PG8_BAR;
    }
    for (;;) {
        const bool has_next = S.next(ui + 1, nxt);
        const char* nA = has_next ? (const char*)g.A + (size_t)nxt.pm * tstep : cA; const char* nB = has_next ? (const char*)g.Bt + (size_t)nxt.pn * tstep : cB;
        for (int t = 0; t < nt; t += 2) {
            const bool last = (t == nt - 2);
            const char* a1 = cA + (size_t)(t + 1) * kstep;
            const char* a2 = last ? nA : cA + (size_t)(t + 2) * kstep; const char* b2 = last ? nB : cB + (size_t)(t + 2) * kstep;
            const char* a3 = a2 + kstep; const char* b3 = b2 + kstep;
            if (last && has_next) S.a_ready(nxt);
            if constexpr (SP2) {
            PG8_LDB(B0, 0, 0); PG8_LDB(B1, 0, 1); PG8_SCHED; PG8_LDA(At, 0, 0); PG8_STAGE(PG8_SA(1, 1), a1 + hstep, voffA);
            PG8_WAIT_V(8); PG8_WAIT_L(0); PG8_BAR; PG8_MMA(0, 0, At, B0); PG8_MMA(0, 1, At, B1); PG8_BAR; PG8_SCHED;
            PG8_LDA(At, 0, 1); PG8_STAGE(PG8_SB(0, 0), b2, voffB); PG8_STAGE(PG8_SB(0, 1), b2 + hstep, voffB); PG8_STAGE(PG8_SA(0, 0), a2, voffA);
            PG8_WAIT_V(8); PG8_WAIT_L(0); PG8_BAR; PG8_MMA(1, 0, At, B0); PG8_MMA(1, 1, At, B1); PG8_BAR; PG8_SCHED;
            PG8_LDB(B0, 1, 0); PG8_LDB(B1, 1, 1); PG8_SCHED; PG8_LDA(At, 1, 0); PG8_STAGE(PG8_SA(0, 1), a2 + hstep, voffA);
            PG8_WAIT_V(8); PG8_WAIT_L(0); PG8_BAR; PG8_MMA(0, 0, At, B0); PG8_MMA(0, 1, At, B1); PG8_BAR; PG8_SCHED;
            PG8_LDA(At, 1, 1); PG8_STAGE(PG8_SB(1, 0), b3, voffB); PG8_STAGE(PG8_SB(1, 1), b3 + hstep, voffB); PG8_STAGE(PG8_SA(1, 0), a3, voffA);
            PG8_WAIT_V(8); PG8_WAIT_L(0); PG8_BAR; PG8_MMA(1, 0, At, B0); PG8_MMA(1, 1, At, B1); PG8_BAR; PG8_SCHED;
            } else {
            PG8_LDB(B0, 0, 0); PG8_SCHED; PG8_LDA(At, 0, 0); PG8_STAGE(PG8_SA(1, 1), a1 + hstep, voffA);
            PG8_WAIT_L(8); PG8_BAR; PG8_WAIT_L(0); PG8_MMA(0, 0, At, B0); PG8_BAR; PG8_SCHED;
            PG8_LDB(B1, 0, 1); PG8_STAGE(PG8_SB(0, 0), b2, voffB);
            PG8_BAR; PG8_WAIT_L(0); PG8_MMA(0, 1, At, B1); PG8_BAR;
            PG8_LDA(At, 0, 1); PG8_STAGE(PG8_SA(0, 0), a2, voffA);
            PG8_BAR; PG8_WAIT_L(0); PG8_MMA(1, 0, At, B0); PG8_BAR; PG8_SCHED;
            PG8_STAGE(PG8_SB(0, 1), b2 + hstep, voffB);
            PG8_WAIT_V(6); PG8_BAR; PG8_MMA(1, 1, At, B1); PG8_BAR;
            PG8_LDB(B0, 1, 0); PG8_SCHED; PG8_LDA(At, 1, 0); PG8_STAGE(PG8_SA(0, 1), a2 + hstep, voffA);
            PG8_WAIT_L(8); PG8_BAR; PG8_WAIT_L(0); PG8_MMA(0, 0, At, B0); PG8_BAR; PG8_SCHED;
            PG8_LDB(B1, 1, 1); PG8_STAGE(PG8_SB(1, 0), b3, voffB);
            PG8_BAR; PG8_WAIT_L(0); PG8_MMA(0, 1, At, B1); PG8_BAR;
            PG8_LDA(At, 1, 1); PG8_STAGE(PG8_SA(1, 0), a3, voffA);
            PG8_BAR; PG8_WAIT_L(0); PG8_MMA(1, 0, At, B0); PG8_BAR; PG8_SCHED;
            PG8_STAGE(PG8_SB(1, 1), b3 + hstep, voffB);
            PG8_WAIT_V(6); PG8_BAR; PG8_MMA(1, 1, At, B1); PG8_BAR;
            }
        }
        if constexpr (ALIGN_EPI) { if (wr == 0) PG8_BAR; }
        if constexpr (!Epi::AFTER_DRAIN) { E(acc, cur, wr, wc, fr, fq); S.done(cur); }
        if (!has_next) break;
#pragma unroll
        for (int a = 0; a < 2; ++a)
#pragma unroll
            for (int b = 0; b < 2; ++b)
#pragma unroll
                for (int m = 0; m < 4; ++m)
#pragma unroll
                    for (int n = 0; n < 2; ++n) acc[a][b][m][n] = (f32x4){0.f, 0.f, 0.f, 0.f};
        cur = nxt; cA = nA; cB = nB; ++ui;
        if constexpr (ALIGN_EPI) { if (wr == 1) PG8_BAR; }
    }
    PG8_WAIT_V(0);
    if constexpr (!ALIGN_EPI) { if (wr == 0) PG8_BAR; }
    PG8_BAR;
    if constexpr (Epi::AFTER_DRAIN) { E.fused(acc, cur, wr, wc, fr, fq, lds, wid, lane); S.done(cur); }
#undef PG8_SA
#undef PG8_SB
#undef PG8_STAGE
#undef PG8_LDA
#undef PG8_LDB
#undef PG8_MMA
#undef PG8_WAIT_V
#undef PG8_WAIT_L
#undef PG8_BAR
#undef PG8_SCHED
}
}

using pg8::bf16_t; using pg8::bf16x8; using pg8::f32x4; using pg8::u32x4; using pg8::Unit;
typedef float f32x16 __attribute__((ext_vector_type(16)));
typedef unsigned u32x2 __attribute__((ext_vector_type(2)));
typedef __bf16 bf16v2 __attribute__((ext_vector_type(2)));
typedef float f32v2 __attribute__((ext_vector_type(2)));
typedef short s16x4 __attribute__((ext_vector_type(4)));

constexpr int SEQ = 16384, CTX = 256, MT = SEQ + CTX, D = 1024, DFF = 2816;
constexpr int NTHR = 512, NWAVE = 8;
constexpr int REP_NORM = 1, REP_FFNIN = 1, REP_FFNOUT = 1, REP_P0 = 1;
constexpr int LDS_BYTES = 131072 + 256;
constexpr float EPS = 1e-6f;
constexpr float LOG2E = 1.4426950408889634f;

__device__ __forceinline__ unsigned pk2(float a, float b) { f32v2 v = {a, b}; return __builtin_bit_cast(unsigned, __builtin_convertvector(v, bf16v2)); }
__device__ __forceinline__ float bf_lo(unsigned u) { return __uint_as_float(u << 16); }
__device__ __forceinline__ float bf_hi(unsigned u) { return __uint_as_float(u & 0xffff0000u); }
__device__ __forceinline__ float bf1(bf16_t h) { return __uint_as_float(((unsigned)h) << 16); }
__device__ __forceinline__ bf16_t f2bf(float f) { return (bf16_t)(pk2(f, 0.f) & 0xffffu); }
__device__ __forceinline__ float wave_sum(float v) {
#pragma unroll
    for (int o = 1; o < 64; o <<= 1) v += __shfl_xor(v, o);
    return v;
}
#define LDS_WAIT() asm volatile("s_waitcnt lgkmcnt(0)" ::: "memory")

constexpr size_t al256(size_t x) { return (x + 255) & ~(size_t)255; }
constexpr size_t WS_X = 0;
constexpr size_t WS_H = WS_X + al256((size_t)MT * D * 4);
constexpr size_t WS_BIG = WS_H + al256((size_t)MT * D * 2);
constexpr size_t WS_MIX = WS_BIG + al256((size_t)MT * 3072 * 2);
constexpr size_t WS_DQKV = WS_MIX + al256((size_t)MT * D * 2);
constexpr size_t WS_CQN = WS_DQKV + al256((size_t)MT * 768 * 2);
constexpr size_t WS_CKVN = WS_CQN + al256((size_t)MT * 384 * 2);
constexpr size_t WS_QF = WS_CKVN + al256((size_t)MT * 256 * 2);
constexpr size_t WS_KF = WS_QF + al256((size_t)8 * MT * 192 * 2);
constexpr size_t WS_VT = WS_KF + al256((size_t)8 * MT * 192 * 2);
constexpr size_t WS_MODP = WS_VT + al256((size_t)1024 * MT * 2);
constexpr size_t WS_MOD = WS_MODP + al256((size_t)4 * 32 * 2 * 9216 * 4);
constexpr size_t WS_WIN = WS_MOD + al256((size_t)4 * 2 * 9216 * 4);
constexpr size_t WS_WOUT = WS_WIN + al256((size_t)8 * 5632 * 1024 * 2);
constexpr size_t WS_MLA_DQKV = WS_WOUT + al256((size_t)8 * 1024 * 2816 * 2);
constexpr size_t WS_MLA_UQ = WS_MLA_DQKV + al256((size_t)768 * 1024 * 2);
constexpr size_t WS_MLA_UK = WS_MLA_UQ + al256((size_t)1536 * 384 * 2);
constexpr size_t WS_MLA_UVT = WS_MLA_UK + al256((size_t)1024 * 256 * 2);
constexpr size_t WS_MLA_O = WS_MLA_UVT + al256((size_t)1024 * 256 * 2);
constexpr size_t WS_POOL = WS_MLA_O + al256((size_t)1024 * 1024 * 2);
constexpr size_t WS_NA_QK = WS_POOL + al256((size_t)1024 * 1024 * 2);
constexpr size_t WS_NA_VT = WS_NA_QK + al256((size_t)2048 * 1024 * 2);
constexpr size_t WS_NA_O = WS_NA_VT + al256((size_t)1024 * 1024 * 2);
constexpr size_t WS_CV_IN = WS_NA_O + al256((size_t)1024 * 1024 * 2);
constexpr size_t WS_CV_OUT = WS_CV_IN + al256((size_t)3072 * 1024 * 2);
constexpr size_t WS_BAR = WS_CV_OUT + al256((size_t)1024 * 1024 * 2);
constexpr size_t WS_END = WS_BAR + al256((size_t)XCD_BAR_WORDS * 4);

struct EpiStore {
    static constexpr bool PERM = true, AFTER_DRAIN = false;
    bf16_t* O; int ldc; int row_base;
    __device__ __forceinline__ void operator()(const f32x4 (&acc)[2][2][4][2], const Unit& u, int wr, int wc, int fr, int fq) const {
        const int row0 = row_base + u.pm * 256 + wr * 64 + fr, col0 = u.pn * 256 + wc * 32 + 8 * fq;
#pragma unroll
        for (int ai = 0; ai < 2; ++ai)
#pragma unroll
            for (int m = 0; m < 4; ++m) { bf16_t* rowp = O + (size_t)(row0 + ai * 128 + m * 16) * ldc + col0;
#pragma unroll
                for (int bj = 0; bj < 2; ++bj) { const f32x4 v0 = acc[ai][bj][m][0], v1 = acc[ai][bj][m][1];
                    u32x4 w; w.x = pk2(v0[0], v0[1]); w.y = pk2(v0[2], v0[3]); w.z = pk2(v1[0], v1[1]); w.w = pk2(v1[2], v1[3]);
                    *(u32x4*)(rowp + bj * 128) = w; } }
    }
};
__device__ __forceinline__ float silu_f(float g) { return g * __builtin_amdgcn_rcpf(1.f + __expf(-g)); }
struct EpiSwiglu {
    static constexpr bool PERM = true, AFTER_DRAIN = false;
    bf16_t* O; int ldc; int row_base;
    __device__ __forceinline__ void operator()(const f32x4 (&acc)[2][2][4][2], const Unit& u, int wr, int wc, int fr, int fq) const {
        const int row0 = row_base + u.pm * 256 + wr * 64 + fr, col0 = u.pn * 128 + wc * 32 + 8 * fq;
#pragma unroll
        for (int ai = 0; ai < 2; ++ai)
#pragma unroll
            for (int m = 0; m < 4; ++m) { bf16_t* rowp = O + (size_t)(row0 + ai * 128 + m * 16) * ldc + col0;
                const f32x4 g0 = acc[ai][0][m][0], g1 = acc[ai][0][m][1], u0 = acc[ai][1][m][0], u1 = acc[ai][1][m][1];
                u32x4 w;
                w.x = pk2(silu_f(g0[0]) * u0[0], silu_f(g0[1]) * u0[1]); w.y = pk2(silu_f(g0[2]) * u0[2], silu_f(g0[3]) * u0[3]);
                w.z = pk2(silu_f(g1[0]) * u1[0], silu_f(g1[1]) * u1[1]); w.w = pk2(silu_f(g1[2]) * u1[2], silu_f(g1[3]) * u1[3]);
                *(u32x4*)rowp = w; }
    }
};
struct EpiResid {
    static constexpr bool PERM = true, AFTER_DRAIN = false;
    const float* xin; float* xout; const float* gate; float coef; int row_base; int out_row_off; int in_row_off;
    __device__ __forceinline__ void operator()(const f32x4 (&acc)[2][2][4][2], const Unit& u, int wr, int wc, int fr, int fq) const {
        const int row0 = row_base + u.pm * 256 + wr * 64 + fr, col0 = u.pn * 256 + wc * 32 + 8 * fq;
        f32x4 gv[2][2];
#pragma unroll
        for (int bj = 0; bj < 2; ++bj)
#pragma unroll
            for (int n = 0; n < 2; ++n) gv[bj][n] = *(const f32x4*)(gate + col0 + bj * 128 + 4 * n) * coef;
#pragma unroll
        for (int ai = 0; ai < 2; ++ai)
#pragma unroll
            for (int m = 0; m < 4; ++m) { const int row = row0 + ai * 128 + m * 16;
                const float* xi = xin + (size_t)(row - in_row_off) * D + col0; float* xo = xout + (size_t)(row - out_row_off) * D + col0;
#pragma unroll
                for (int bj = 0; bj < 2; ++bj)
#pragma unroll
                    for (int n = 0; n < 2; ++n) { const f32x4 xv = *(const f32x4*)(xi + bj * 128 + 4 * n);
                        *(f32x4*)(xo + bj * 128 + 4 * n) = xv + gv[bj][n] * acc[ai][bj][m][n]; } }
    }
};
struct EpiNaQK {
    static constexpr bool PERM = true, AFTER_DRAIN = false;
    bf16_t* QN; bf16_t* KN; const float* g_q; const float* g_k; float qscale;
    __device__ __forceinline__ void operator()(const f32x4 (&acc)[2][2][4][2], const Unit& u, int wr, int wc, int fr, int fq) const {
        const int hh = u.pn * 4 + wc; const bool isq = hh < 16; const int h = hh & 15;
        const float* g = isq ? g_q : g_k; const float sc = isq ? qscale : 1.f;
        bf16_t* outb = (isq ? QN : KN) + (size_t)h * MT * 64;
        f32x4 gv[2][2];
#pragma unroll
        for (int bj = 0; bj < 2; ++bj)
#pragma unroll
            for (int n = 0; n < 2; ++n) gv[bj][n] = *(const f32x4*)(g + 32 * bj + 8 * fq + 4 * n) * sc;
        const int row0 = u.pm * 256 + wr * 64 + fr;
#pragma unroll
        for (int ai = 0; ai < 2; ++ai)
#pragma unroll
            for (int m = 0; m < 4; ++m) { const int row = row0 + ai * 128 + m * 16;
                float ss = 0.f;
#pragma unroll
                for (int bj = 0; bj < 2; ++bj)
#pragma unroll
                    for (int n = 0; n < 2; ++n) { const f32x4 v = acc[ai][bj][m][n]; ss += (v[0] * v[0] + v[1] * v[1]) + (v[2] * v[2] + v[3] * v[3]); }
                ss += __shfl_xor(ss, 16); ss += __shfl_xor(ss, 32);
                const float rinv = rsqrtf(ss * (1.f / 64.f) + EPS);
#pragma unroll
                for (int bj = 0; bj < 2; ++bj) { const f32x4 v0 = acc[ai][bj][m][0] * gv[bj][0] * rinv, v1 = acc[ai][bj][m][1] * gv[bj][1] * rinv;
                    u32x4 w; w.x = pk2(v0[0], v0[1]); w.y = pk2(v0[2], v0[3]); w.z = pk2(v1[0], v1[1]); w.w = pk2(v1[2], v1[3]);
                    *(u32x4*)(outb + (size_t)row * 64 + 32 * bj + 8 * fq) = w; } }
    }
};
struct EpiMulPair {
    static constexpr bool PERM = true, AFTER_DRAIN = false;
    bf16_t* O; int ldc; int row_base;
    __device__ __forceinline__ void operator()(const f32x4 (&acc)[2][2][4][2], const Unit& u, int wr, int wc, int fr, int fq) const {
        const int row0 = row_base + u.pm * 256 + wr * 64 + fr, col0 = u.pn * 128 + wc * 32 + 8 * fq;
#pragma unroll
        for (int ai = 0; ai < 2; ++ai)
#pragma unroll
            for (int m = 0; m < 4; ++m) { bf16_t* rowp = O + (size_t)(row0 + ai * 128 + m * 16) * ldc + col0;
                const f32x4 p0 = acc[ai][0][m][0] * acc[ai][1][m][0], p1 = acc[ai][0][m][1] * acc[ai][1][m][1];
                u32x4 w; w.x = pk2(p0[0], p0[1]); w.y = pk2(p0[2], p0[3]); w.z = pk2(p1[0], p1[1]); w.w = pk2(p1[2], p1[3]);
                *(u32x4*)rowp = w; }
    }
};
template <class Epi>
__device__ __forceinline__ void run_gemm(LAS unsigned char* lds, const bf16_t* A, const bf16_t* Bt, int M, int N, int K, const Epi& E, int rot) {
    pg8::Gemm g{A, Bt, M, N, K}; pg8::StaticOrder S; S.init(M, N, (int)gridDim.x, (int)((blockIdx.x + (unsigned)rot) % gridDim.x));
    pg8::gemm_phase<Epi, pg8::StaticOrder, true, true>(lds, g, S, E);
}

template <int K>
__device__ __forceinline__ void ctx_resid(LAS unsigned char* lds, const bf16_t* __restrict__ A, const bf16_t* __restrict__ Bt, const float* Xin, float* X,
                                          const float* __restrict__ gate, float coef) {
    const int tid = opaque_tid(), wave = tid >> 6, lane = tid & 63, fr = lane & 15, fq = lane >> 4;
    LAS float* part = (LAS float*)lds;
    constexpr int kw = K / 8;
    for (int p = blockIdx.x; p < 256; p += gridDim.x) {
        const int rb = p >> 4, cb = p & 15;
        f32x4 acc[4];
#pragma unroll
        for (int j = 0; j < 4; ++j) acc[j] = (f32x4){0.f, 0.f, 0.f, 0.f};
        const bf16_t* ap = A + (size_t)(16 * rb + fr) * K + wave * kw + 8 * fq;
        const bf16_t* bp = Bt + (size_t)(64 * cb + fr) * K + wave * kw + 8 * fq;
        const int erow = tid >> 5, ecol = (tid & 31) * 2; const size_t xo = (size_t)(16 * rb + erow) * D + 64 * cb + ecol;
        f32v2 xv = *(const f32v2*)(Xin + xo); const f32v2 gvv = *(const f32v2*)(gate + 64 * cb + ecol);
#pragma unroll
        for (int k = 0; k < kw; k += 32) {
            const bf16x8 a = *(const bf16x8*)(ap + k);
#pragma unroll
            for (int j = 0; j < 4; ++j) { const bf16x8 b = *(const bf16x8*)(bp + (size_t)(16 * j) * K + k); acc[j] = __builtin_amdgcn_mfma_f32_16x16x32_bf16(b, a, acc[j], 0, 0, 0); }
        }
#pragma unroll
        for (int j = 0; j < 4; ++j) *(LAS f32x4*)(part + (wave * 16 + fr) * 64 + 16 * j + 4 * fq) = acc[j];
        __syncthreads();
        { float s0 = 0.f, s1 = 0.f;
#pragma unroll
            for (int w = 0; w < 8; ++w) { const f32v2 v = *(const LAS f32v2*)(part + (w * 16 + erow) * 64 + ecol); s0 += v.x; s1 += v.y; }
            xv.x += coef * gvv.x * s0; xv.y += coef * gvv.y * s1; *(f32v2*)(X + xo) = xv; }
        __syncthreads();
    }
}

__device__ __forceinline__ void ctx_resid_pool(LAS unsigned char* lds, const bf16_t* __restrict__ Yg, const bf16_t* __restrict__ Wg, float* X, const float* __restrict__ gate) {
    const int tid = opaque_tid(), wave = tid >> 6, lane = tid & 63, fr = lane & 15, fq = lane >> 4;
    LAS float* part = (LAS float*)lds;
    for (int p = blockIdx.x; p < 256; p += gridDim.x) {
        const int g = p >> 6, rb = (p >> 2) & 15, cb = p & 3;
        const int erow = tid >> 5, ecol = (tid & 31) * 2; const size_t xo = (size_t)(16 * rb + erow) * D + 256 * g + 64 * cb + ecol;
        f32v2 xv = *(const f32v2*)(X + xo); const f32v2 gvv = *(const f32v2*)(gate + 256 * g + 64 * cb + ecol);
        const bf16x8 a = *(const bf16x8*)(Yg + ((size_t)g * MT + 16 * rb + fr) * 256 + 32 * wave + 8 * fq);
        f32x4 acc[4];
#pragma unroll
        for (int j = 0; j < 4; ++j) { const bf16x8 b = *(const bf16x8*)(Wg + ((size_t)g * 256 + 64 * cb + 16 * j + fr) * 256 + 32 * wave + 8 * fq);
            acc[j] = __builtin_amdgcn_mfma_f32_16x16x32_bf16(b, a, (f32x4){0.f, 0.f, 0.f, 0.f}, 0, 0, 0); }
#pragma unroll
        for (int j = 0; j < 4; ++j) *(LAS f32x4*)(part + (wave * 16 + fr) * 64 + 16 * j + 4 * fq) = acc[j];
        __syncthreads();
        { float s0 = 0.f, s1 = 0.f;
#pragma unroll
            for (int w = 0; w < 8; ++w) { const f32v2 v = *(const LAS f32v2*)(part + (w * 16 + erow) * 64 + ecol); s0 += v.x; s1 += v.y; }
            xv.x += gvv.x * s0; xv.y += gvv.y * s1; *(f32v2*)(X + xo) = xv; }
        __syncthreads();
    }
}

__device__ __forceinline__ void tr_item(const float* __restrict__ W, int ldw, int k0, int sc0, bf16_t* __restrict__ WT, int ldt, int dr0, int dc0,
                                        const float* __restrict__ scale, LAS float* scr, int lane) {
#pragma unroll 16
    for (int i = 0; i < 32; ++i) { const int kk = 2 * i + (lane >> 5); scr[kk * 33 + (lane & 31)] = W[(size_t)(k0 + kk) * ldw + sc0 + (lane & 31)]; }
    LDS_WAIT();
    const int c = lane & 7;
#pragma unroll
    for (int j = 0; j < 4; ++j) { const int n = (lane >> 3) + 8 * j; const LAS float* s = scr + (8 * c) * 33 + n;
        const float sc = scale ? scale[dr0 + n] : 1.f;
        u32x4 o; o.x = pk2(s[0 * 33] * sc, s[1 * 33] * sc); o.y = pk2(s[2 * 33] * sc, s[3 * 33] * sc); o.z = pk2(s[4 * 33] * sc, s[5 * 33] * sc); o.w = pk2(s[6 * 33] * sc, s[7 * 33] * sc);
        *(u32x4*)(WT + (size_t)(dr0 + n) * ldt + dc0 + k0 + 8 * c) = o; }
    LDS_WAIT();
}
struct ConvCtx { long base; int gw, ngw, lane; LAS float* scr; };
__device__ __forceinline__ void conv_job(ConvCtx& c, const float* W, int ldw, int K, int sc0, int ncols, bf16_t* WT, int ldt, int dr0, int dc0, const float* scale, int mode) {
    const int nblk = ncols / 32; const long n_items = (long)(K / 64) * nblk;
    long rem = ((long)c.gw - c.base) % c.ngw; if (rem < 0) rem += c.ngw;
    for (long g = c.base + rem; g < c.base + n_items; g += c.ngw) {
        const int it = (int)(g - c.base), kb = it / nblk, nb = it % nblk, n0 = 32 * nb;
        int src_col = sc0 + n0;
        if (mode == 1) { const int pn = n0 >> 8, bj = (n0 >> 7) & 1, j0 = n0 & 127; src_col = bj * DFF + 128 * pn + j0; }
        if (mode == 3) { const int pn = n0 >> 8, bj = (n0 >> 7) & 1, j0 = n0 & 127; src_col = sc0 + bj * 1024 + 128 * pn + j0; }
        if (mode == 2) { const int pn = n0 >> 8, bj = (n0 >> 7) & 1, wcc = (n0 >> 5) & 3; src_col = sc0 + (pn * 4 + wcc) * 64 + 32 * bj; }
        tr_item(W, ldw, 64 * kb, src_col, WT, ldt, dr0 + n0, dc0, scale, c.scr, c.lane);
    }
    c.base += n_items;
}

__device__ __forceinline__ void norm_phase(const float* __restrict__ Xc, const float* __restrict__ Xl, bf16_t* __restrict__ H, const float* __restrict__ modL, int i_shift, int i_scale, int row_begin) {
    const int tid_ = opaque_tid(), lane = tid_ & 63, gw = blockIdx.x * NWAVE + (tid_ >> 6), ngw = gridDim.x * NWAVE;
    for (int row = row_begin + gw; row < MT; row += ngw) {
        const float* mp = modL + (row >= CTX ? 9216 : 0);
        const f32x4* xr = (const f32x4*)(row >= CTX ? Xl + (size_t)(row - CTX) * D : Xc + (size_t)row * D) + lane;
        f32x4 v[4]; float ss = 0.f;
#pragma unroll
        for (int j = 0; j < 4; ++j) { v[j] = xr[64 * j]; ss += (v[j].x * v[j].x + v[j].y * v[j].y) + (v[j].z * v[j].z + v[j].w * v[j].w); }
        const float rinv = rsqrtf(wave_sum(ss) * (1.f / D) + EPS);
        u32x2* o = (u32x2*)(H + (size_t)row * D) + lane;
#pragma unroll
        for (int j = 0; j < 4; ++j) {
            const f32x4 sh = *((const f32x4*)(mp + i_shift * D) + lane + 64 * j), sc = *((const f32x4*)(mp + i_scale * D) + lane + 64 * j);
            const f32x4 h = v[j] * rinv * (sc + 1.f) + sh;
            u32x2 w; w.x = pk2(h.x, h.y); w.y = pk2(h.z, h.w); o[64 * j] = w; }
    }
}

__device__ __forceinline__ float rope_elem(float val, float oth, int e, int t) {
    if (t < 0) return val;
    const int p = e >> 1, fi = p & 15;
    const float freq = __builtin_amdgcn_exp2f(-(float)fi * (13.287712379549449f / 16.f));
    const float pos = (p < 16) ? (float)(t >> 6) : (float)(t & 63);
    const float rev = pos * freq * 0.15915494309189535f, fr_ = rev - floorf(rev);
    const float sn = __builtin_amdgcn_sinf(fr_), cs = __builtin_amdgcn_cosf(fr_);
    return (e & 1) ? (oth * sn + val * cs) : (val * cs - oth * sn);
}

__device__ __forceinline__ void mla_na_phase(const bf16_t* __restrict__ R, bf16_t* __restrict__ CQN, bf16_t* __restrict__ CKVN, bf16_t* __restrict__ KF,
                                             const float* __restrict__ g_dq, const float* __restrict__ g_dkv, const float* __restrict__ g_kr) {
    const int tid_ = opaque_tid(), lane = tid_ & 63, gw = blockIdx.x * NWAVE + (tid_ >> 6), ngw = gridDim.x * NWAVE;
    for (int rowa = gw; rowa < MT; rowa += 2 * ngw) {
        int rows[2] = {rowa, min(rowa + ngw, MT - 1)};
        unsigned q[2][3]; u32x2 kv[2]; float kr[2], ss[2], sk[2], sr[2];
#pragma unroll
        for (int u = 0; u < 2; ++u) { const bf16_t* r = R + (size_t)rows[u] * 768;
#pragma unroll
            for (int j = 0; j < 3; ++j) q[u][j] = *((const unsigned*)r + lane + 64 * j);
            kv[u] = *((const u32x2*)(r + 384) + lane); kr[u] = bf1(r[640 + lane]); }
#pragma unroll
        for (int u = 0; u < 2; ++u) { float s_ = 0.f;
#pragma unroll
            for (int j = 0; j < 3; ++j) { const float a = bf_lo(q[u][j]), b = bf_hi(q[u][j]); s_ += a * a + b * b; }
            ss[u] = s_;
            const float k0 = bf_lo(kv[u].x), k1 = bf_hi(kv[u].x), k2 = bf_lo(kv[u].y), k3 = bf_hi(kv[u].y);
            sk[u] = k0 * k0 + k1 * k1 + k2 * k2 + k3 * k3; sr[u] = kr[u] * kr[u]; }
#pragma unroll
        for (int o = 1; o < 64; o <<= 1)
#pragma unroll
            for (int u = 0; u < 2; ++u) { ss[u] += __shfl_xor(ss[u], o); sk[u] += __shfl_xor(sk[u], o); sr[u] += __shfl_xor(sr[u], o); }
#pragma unroll
        for (int u = 0; u < 2; ++u) { const int row = rows[u];
            const float rq = rsqrtf(ss[u] * (1.f / 384.f) + EPS), rk = rsqrtf(sk[u] * (1.f / 256.f) + EPS), rr = rsqrtf(sr[u] * (1.f / 64.f) + EPS);
#pragma unroll
            for (int j = 0; j < 3; ++j) { const int e = 2 * lane + 128 * j;
                *((unsigned*)(CQN + (size_t)row * 384) + lane + 64 * j) = pk2(bf_lo(q[u][j]) * rq * g_dq[e], bf_hi(q[u][j]) * rq * g_dq[e + 1]); }
            const float k0 = bf_lo(kv[u].x), k1 = bf_hi(kv[u].x), k2 = bf_lo(kv[u].y), k3 = bf_hi(kv[u].y);
            u32x2 w; w.x = pk2(k0 * rk * g_dkv[4 * lane], k1 * rk * g_dkv[4 * lane + 1]); w.y = pk2(k2 * rk * g_dkv[4 * lane + 2], k3 * rk * g_dkv[4 * lane + 3]);
            *((u32x2*)(CKVN + (size_t)row * 256) + lane) = w;
            const float val = kr[u] * rr * g_kr[lane], oth = __shfl_xor(val, 1);
            const bf16_t ko = f2bf(rope_elem(val, oth, lane, row - CTX));
#pragma unroll
            for (int h = 0; h < 8; ++h) KF[((size_t)h * MT + row) * 192 + 128 + lane] = ko; }
    }
}
__device__ __forceinline__ void mla_nb_phase(const bf16_t* __restrict__ QR, const bf16_t* __restrict__ KR, bf16_t* __restrict__ QF, bf16_t* __restrict__ KF,
                                             const float* __restrict__ g_qn, const float* __restrict__ g_qr, const float* __restrict__ g_kn, float qscale) {
    const int tid_ = opaque_tid(), lane = tid_ & 63, gw = blockIdx.x * NWAVE + (tid_ >> 6), ngw = gridDim.x * NWAVE;
    const float gq0 = g_qn[2 * lane], gq1 = g_qn[2 * lane + 1], gk0 = g_kn[2 * lane], gk1 = g_kn[2 * lane + 1], gr = g_qr[lane];
    for (int row = gw; row < MT; row += ngw) {
#pragma unroll 4
        for (int h = 0; h < 8; ++h) {
            const bf16_t* q = QR + (size_t)row * 1536 + h * 192;
            const unsigned qn = *((const unsigned*)q + lane); const float qrv = bf1(q[128 + lane]);
            const unsigned kn = *((const unsigned*)(KR + (size_t)row * 1024 + h * 128) + lane);
            const float a = bf_lo(qn), b = bf_hi(qn), c = bf_lo(kn), d = bf_hi(kn);
            const float r1 = rsqrtf(wave_sum(a * a + b * b) * (1.f / 128.f) + EPS);
            const float r2 = rsqrtf(wave_sum(qrv * qrv) * (1.f / 64.f) + EPS);
            const float r3 = rsqrtf(wave_sum(c * c + d * d) * (1.f / 128.f) + EPS);
            bf16_t* qo = QF + ((size_t)h * MT + row) * 192;
            *((unsigned*)qo + lane) = pk2(a * r1 * gq0 * qscale, b * r1 * gq1 * qscale);
            const float val = qrv * r2 * gr, oth = __shfl_xor(val, 1);
            qo[128 + lane] = f2bf(rope_elem(val, oth, lane, row - CTX) * qscale);
            *((unsigned*)(KF + ((size_t)h * MT + row) * 192) + lane) = pk2(c * r3 * gk0, d * r3 * gk1);
        }
    }
}
__device__ __forceinline__ void na_norm_phase(const bf16_t* __restrict__ R, bf16_t* __restrict__ QN, bf16_t* __restrict__ KN,
                                              const float* __restrict__ g_q, const float* __restrict__ g_k, float qscale) {
    const int tid_ = opaque_tid(), lane = tid_ & 63, gw = blockIdx.x * NWAVE + (tid_ >> 6), ngw = gridDim.x * NWAVE;
    const int e0 = 8 * (lane & 7);
    for (int row = gw; row < MT; row += ngw) {
#pragma unroll
        for (int j = 0; j < 4; ++j) {
            const u32x4 v = *((const u32x4*)(R + (size_t)row * 2048 + j * 512) + lane);
            float f[8] = {bf_lo(v.x), bf_hi(v.x), bf_lo(v.y), bf_hi(v.y), bf_lo(v.z), bf_hi(v.z), bf_lo(v.w), bf_hi(v.w)};
            float ss = 0.f;
#pragma unroll
            for (int i = 0; i < 8; ++i) ss += f[i] * f[i];
            ss += __shfl_xor(ss, 1); ss += __shfl_xor(ss, 2); ss += __shfl_xor(ss, 4);
            const float rinv = rsqrtf(ss * (1.f / 64.f) + EPS);
            const int seg = j * 8 + (lane >> 3);
            const bool isq = seg < 16; const int h = seg & 15;
            const float* g = isq ? g_q : g_k; const float sc = isq ? rinv * qscale : rinv;
            u32x4 w; w.x = pk2(f[0] * sc * g[e0], f[1] * sc * g[e0 + 1]); w.y = pk2(f[2] * sc * g[e0 + 2], f[3] * sc * g[e0 + 3]);
            w.z = pk2(f[4] * sc * g[e0 + 4], f[5] * sc * g[e0 + 5]); w.w = pk2(f[6] * sc * g[e0 + 6], f[7] * sc * g[e0 + 7]);
            *(u32x4*)((isq ? QN : KN) + ((size_t)h * MT + row) * 64 + e0) = w;
        }
    }
}
template <int G>
__device__ __forceinline__ void pool_group(const bf16_t* __restrict__ H, bf16_t* __restrict__ Y) {
    constexpr int HALF = 1 << G, W = 2 * HALF;
    const long n = (long)MT * 32, stride = (long)gridDim.x * NTHR;
    for (long idx = (long)blockIdx.x * NTHR + opaque_tid(); idx < n; idx += stride) {
        const int row = (int)(idx >> 5), ch = G * 32 + (int)(idx & 31);
        const int base = row >= CTX ? CTX : 0, T = row >= CTX ? SEQ : CTX, ts = row - base;
        const int lo = max(ts - HALF, 0), hi = min(ts + HALF, T);
        u32x4 v[W];
#pragma unroll
        for (int j = 0; j < W; ++j) { const int r = min(max(ts - HALF + j, 0), T - 1); v[j] = *((const u32x4*)(H + (size_t)(base + r) * D) + ch); }
        const u32x4 c = *((const u32x4*)(H + (size_t)row * D) + ch);
        float s[8] = {0, 0, 0, 0, 0, 0, 0, 0};
#pragma unroll
        for (int j = 0; j < W; ++j) { const int r = ts - HALF + j; const float wgt = (r >= lo && r < hi) ? 1.f : 0.f;
            s[0] += wgt * bf_lo(v[j].x); s[1] += wgt * bf_hi(v[j].x); s[2] += wgt * bf_lo(v[j].y); s[3] += wgt * bf_hi(v[j].y);
            s[4] += wgt * bf_lo(v[j].z); s[5] += wgt * bf_hi(v[j].z); s[6] += wgt * bf_lo(v[j].w); s[7] += wgt * bf_hi(v[j].w); }
        const float inv = 1.f / (float)(hi - lo);
        u32x4 w; w.x = pk2(s[0] * inv - bf_lo(c.x), s[1] * inv - bf_hi(c.x)); w.y = pk2(s[2] * inv - bf_lo(c.y), s[3] * inv - bf_hi(c.y));
        w.z = pk2(s[4] * inv - bf_lo(c.z), s[5] * inv - bf_hi(c.z)); w.w = pk2(s[6] * inv - bf_lo(c.w), s[7] * inv - bf_hi(c.w));
        *((u32x4*)(Y + ((size_t)G * MT + row) * 256) + (int)(idx & 31)) = w;
    }
}
__device__ __forceinline__ void pool_phase(const bf16_t* __restrict__ H, bf16_t* __restrict__ Y) {
    pool_group<0>(H, Y); pool_group<1>(H, Y); pool_group<2>(H, Y); pool_group<3>(H, Y);
}
__device__ __forceinline__ void conv_phase(const bf16_t* __restrict__ CU, const bf16_t* __restrict__ Bg, bf16_t* __restrict__ G, const float* __restrict__ cw) {
    const long n = (long)MT * 128, stride = (long)gridDim.x * NTHR;
    for (long idx = (long)CTX * 128 + (long)blockIdx.x * NTHR + opaque_tid(); idx < n; idx += stride) {
        const int row = (int)(idx >> 7), ch = (int)(idx & 127);
        float z[8] = {0, 0, 0, 0, 0, 0, 0, 0};
#pragma unroll
        for (int k = 0; k < 3; ++k) { const int r = row + k - 1;
            if (r >= CTX && r < MT) {
                const u32x4 c = *((const u32x4*)(CU + (size_t)r * D) + ch);
                const f32x4 w0 = *((const f32x4*)(cw + k * D) + 2 * ch), w1 = *((const f32x4*)(cw + k * D) + 2 * ch + 1);
                z[0] += w0.x * bf_lo(c.x); z[1] += w0.y * bf_hi(c.x); z[2] += w0.z * bf_lo(c.y); z[3] += w0.w * bf_hi(c.y);
                z[4] += w1.x * bf_lo(c.z); z[5] += w1.y * bf_hi(c.z); z[6] += w1.z * bf_lo(c.w); z[7] += w1.w * bf_hi(c.w); } }
        const u32x4 b = *((const u32x4*)(Bg + (size_t)row * D) + ch);
        u32x4 w; w.x = pk2(z[0] * bf_lo(b.x), z[1] * bf_hi(b.x)); w.y = pk2(z[2] * bf_lo(b.y), z[3] * bf_hi(b.y));
        w.z = pk2(z[4] * bf_lo(b.z), z[5] * bf_hi(b.z)); w.w = pk2(z[6] * bf_lo(b.w), z[7] * bf_hi(b.w));
        *((u32x4*)(G + (size_t)row * D) + ch) = w;
    }
}

template <int DQK, int DV, bool NA>
__device__ __forceinline__ void attn_phase(LAS unsigned char* lds, const bf16_t* __restrict__ Q, const bf16_t* __restrict__ Kf, const bf16_t* __restrict__ VT,
                                           bf16_t* __restrict__ O, const float* __restrict__ rpb, int H, bool with_ctx) {
    constexpr int KSTR = (DQK + 8) * 2, VSTR = (64 + 8) * 2, KBUF = 64 * KSTR, VBUF = DV * VSTR;
    constexpr int KCH = DQK / 8, NKL = 64 * KCH / NTHR, NVL = DV * 8 / NTHR, NKS = DQK / 16, NDV = DV / 32;
    constexpr int RPB_OFF = 2 * KBUF + 2 * VBUF;
    const int tid = opaque_tid(), wave = tid >> 6, lane = tid & 63, r = lane & 31, hh = lane >> 5;
    LAS float* rpbL = (LAS float*)(lds + RPB_OFF);
    const int nbig = 64 * H, nunits = with_ctx ? 65 * H : 64 * H;
    for (int u = blockIdx.x; u < nunits; u += gridDim.x) {
        int head, qb;
        if (u < nbig) { const int b = u & 255, rnd = u >> 8, xcd = b & 7, slot = b >> 3; head = xcd + 8 * (rnd >> 1); qb = 1 + (rnd & 1) * 32 + slot; }
        else { head = u - nbig; qb = 0; }
        int nloc = 0, rlo = 0, NT;
        if (!NA) NT = (qb == 0) ? 4 : 260;
        else { if (qb > 0) { const int r0 = 4 * (qb - 1); rlo = min(max(r0 - 4, 0), 248); const int rhi = min(max(r0 - 1, 0), 248) + 7; nloc = rhi - rlo + 1; } NT = nloc + 4; }
#define TILE_ROW0(t) (!NA ? 64 * (t) : ((t) < nloc ? CTX + 64 * (rlo + (t)) : 64 * ((t) - nloc)))
        const int qrow = 256 * qb + 32 * wave + r;
        const int rq = 4 * (qb - 1) + (wave >> 1), cq = 32 * (wave & 1) + r;
        const int rs = min(max(rq - 4, 0), 248), cs = min(max(cq - 8, 0), 48);
        bf16x8 qf[NKS];
#pragma unroll
        for (int ks = 0; ks < NKS; ++ks) qf[ks] = *(const bf16x8*)(Q + ((size_t)head * MT + qrow) * DQK + 16 * ks + 8 * hh);
        u32x4 kreg[NKL], vreg[NVL];
#define ATT_LOAD(t) do { const int row0_ = TILE_ROW0(t); \
        _Pragma("unroll") for (int i = 0; i < NKL; ++i) { const int c_ = tid + NTHR * i, kr_ = c_ / KCH, kc_ = c_ % KCH; kreg[i] = *(const u32x4*)(Kf + ((size_t)head * MT + row0_ + kr_) * DQK + kc_ * 8); } \
        _Pragma("unroll") for (int i = 0; i < NVL; ++i) { const int c_ = tid + NTHR * i, vr_ = c_ >> 3, vc_ = c_ & 7; vreg[i] = *(const u32x4*)(VT + (size_t)(head * DV + vr_) * MT + row0_ + vc_ * 8); } } while (0)
#define ATT_STORE(buf) do { \
        _Pragma("unroll") for (int i = 0; i < NKL; ++i) { const int c_ = tid + NTHR * i, kr_ = c_ / KCH, kc_ = c_ % KCH; *(LAS u32x4*)(lds + (buf) * KBUF + kr_ * KSTR + kc_ * 16) = kreg[i]; } \
        _Pragma("unroll") for (int i = 0; i < NVL; ++i) { const int c_ = tid + NTHR * i, vr_ = c_ >> 3, vc_ = c_ & 7; *(LAS u32x4*)(lds + 2 * KBUF + (buf) * VBUF + vr_ * VSTR + vc_ * 16) = vreg[i]; } } while (0)
        ATT_LOAD(0); ATT_STORE(0);
        if (NA) { for (int i = tid; i < 15 * 31; i += NTHR) rpbL[i] = rpb[head * (15 * 31) + i] * LOG2E; }
        __syncthreads();
        float mrun = -INFINITY, lsum = 0.f;
        f32x16 o[NDV];
#pragma unroll
        for (int d = 0; d < NDV; ++d)
#pragma unroll
            for (int i = 0; i < 16; ++i) o[d][i] = 0.f;
        for (int t = 0; t < NT; ++t) {
            const int cur = t & 1;
            if (t + 1 < NT) ATT_LOAD(t + 1);
            bool active = true; int rr = 0; const bool local = NA && (t < nloc);
            if (local) { rr = rlo + t; active = (rr >= rs) && (rr < rs + 8); }
            if (active) {
                f32x16 s[2];
#pragma unroll
                for (int kb = 0; kb < 2; ++kb) {
#pragma unroll
                    for (int i = 0; i < 16; ++i) s[kb][i] = 0.f;
#pragma unroll
                    for (int ks = 0; ks < NKS; ++ks) {
                        const bf16x8 a = *(const LAS bf16x8*)(lds + cur * KBUF + (32 * kb + r) * KSTR + (16 * ks + 8 * hh) * 2);
                        s[kb] = __builtin_amdgcn_mfma_f32_32x32x16_bf16(a, qf[ks], s[kb], 0, 0, 0);
                    }
                }
                if (local) {
                    const int dr = rr - rq + 7;
#pragma unroll
                    for (int kb = 0; kb < 2; ++kb)
#pragma unroll
                        for (int i = 0; i < 16; ++i) { const int kc = 32 * kb + (i & 3) + 8 * (i >> 2) + 4 * hh; const bool valid = (kc >= cs) && (kc < cs + 16);
                            const int dc = min(max(kc - cq + 15, 0), 30);
                            const float bias = rpbL[dr * 31 + dc];
                            s[kb][i] = valid ? s[kb][i] + bias : -INFINITY; }
                }
                float mx = s[0][0];
#pragma unroll
                for (int i = 1; i < 16; ++i) mx = fmaxf(mx, s[0][i]);
#pragma unroll
                for (int i = 0; i < 16; ++i) mx = fmaxf(mx, s[1][i]);
                mx = fmaxf(mx, __shfl_xor(mx, 32));
                const float mnew = fmaxf(mrun, mx), alpha = __builtin_amdgcn_exp2f(mrun - mnew);
                mrun = mnew;
                float ps = 0.f;
#pragma unroll
                for (int kb = 0; kb < 2; ++kb)
#pragma unroll
                    for (int i = 0; i < 16; ++i) { s[kb][i] = __builtin_amdgcn_exp2f(s[kb][i] - mnew); ps += s[kb][i]; }
                lsum = lsum * alpha + ps;
#pragma unroll
                for (int d = 0; d < NDV; ++d)
#pragma unroll
                    for (int i = 0; i < 16; ++i) o[d][i] *= alpha;
#pragma unroll
                for (int kb = 0; kb < 2; ++kb)
#pragma unroll
                    for (int sx = 0; sx < 2; ++sx) {
                        u32x4 pw; pw.x = pk2(s[kb][8 * sx + 0], s[kb][8 * sx + 1]); pw.y = pk2(s[kb][8 * sx + 2], s[kb][8 * sx + 3]);
                        pw.z = pk2(s[kb][8 * sx + 4], s[kb][8 * sx + 5]); pw.w = pk2(s[kb][8 * sx + 6], s[kb][8 * sx + 7]);
                        const bf16x8 pb = __builtin_bit_cast(bf16x8, pw);
#pragma unroll
                        for (int d = 0; d < NDV; ++d) {
                            const LAS unsigned char* vp = lds + 2 * KBUF + cur * VBUF + (32 * d + r) * VSTR + (32 * kb + 16 * sx + 4 * hh) * 2;
                            const u32x2 v0 = *(const LAS u32x2*)vp, v1 = *(const LAS u32x2*)(vp + 16);
                            u32x4 vw; vw.x = v0.x; vw.y = v0.y; vw.z = v1.x; vw.w = v1.y;
                            o[d] = __builtin_amdgcn_mfma_f32_32x32x16_bf16(__builtin_bit_cast(bf16x8, vw), pb, o[d], 0, 0, 0);
                        }
                    }
            }
            if (t + 1 < NT) ATT_STORE(cur ^ 1);
            __syncthreads();
        }
        const float ltot = lsum + __shfl_xor(lsum, 32), inv = 1.f / ltot;
        bf16_t* orow = O + (size_t)qrow * (H * DV) + head * DV;
#pragma unroll
        for (int d = 0; d < NDV; ++d)
#pragma unroll
            for (int g = 0; g < 4; ++g) { u32x2 w; w.x = pk2(o[d][4 * g] * inv, o[d][4 * g + 1] * inv); w.y = pk2(o[d][4 * g + 2] * inv, o[d][4 * g + 3] * inv);
                *(u32x2*)(orow + 32 * d + 8 * g + 4 * hh) = w; }
#undef ATT_LOAD
#undef ATT_STORE
#undef TILE_ROW0
    }
}

__device__ __forceinline__ void attn_na16_phase(LAS unsigned char* lds, const bf16_t* __restrict__ Q, const bf16_t* __restrict__ Kf, const bf16_t* __restrict__ VT, bf16_t* __restrict__ O,
                                                const float* __restrict__ rpb) {
    constexpr int H = 16, HD = 64, KSTR = 144, VSTR = 144, KBUF = 64 * KSTR, VBUF = 64 * VSTR, RPB_OFF = 2 * KBUF + 2 * VBUF;
    const int tid = opaque_tid(), wave = tid >> 6, lane = tid & 63, r = lane & 31, hh = lane >> 5;
    LAS float* rpbL = (LAS float*)(lds + RPB_OFF);
    const int cg_ = wave & 3, rp = wave >> 2, kc0 = min(max(16 * cg_ - 8, 0), 32);
    for (int u = blockIdx.x; u < 64 * H; u += gridDim.x) {
        const int b = u & 255, rnd = u >> 8, xcd = b & 7, slot = b >> 3, head = xcd + 8 * (rnd >> 1), qb = (rnd & 1) * 32 + slot;
        const int r0 = 4 * qb, rlo = min(max(r0 - 4, 0), 248), rhi = min(max(r0 - 1, 0), 248) + 7, nloc = rhi - rlo + 1, NT = nloc + 4;
        const int rq = r0 + 2 * rp + (r >> 4), cq = 16 * cg_ + (r & 15);
        const int rs = min(max(rq - 4, 0), 248), cs = min(max(cq - 8, 0), 48);
        const int wlo = min(max(r0 + 2 * rp - 4, 0), 248), whi = min(max(r0 + 2 * rp - 3, 0), 248) + 7;
        const int qrow = CTX + 64 * rq + cq;
        unsigned vmask = 0u;
#pragma unroll
        for (int i = 0; i < 16; ++i) { const int kc_ = kc0 + (i & 3) + 8 * (i >> 2) + 4 * hh; if (kc_ >= cs && kc_ < cs + 16) vmask |= 1u << i; }
        const int dcb = kc0 + 4 * hh - cq + 15;
        bf16x8 qf[4];
#pragma unroll
        for (int ks = 0; ks < 4; ++ks) qf[ks] = *(const bf16x8*)(Q + ((size_t)head * MT + qrow) * HD + 16 * ks + 8 * hh);
        u32x4 kreg, vreg;
#define NA_ROW0(t) ((t) < nloc ? CTX + 64 * (rlo + (t)) : 64 * ((t) - nloc))
#define NA_LOAD(t) do { const int row0_ = NA_ROW0(t); kreg = *(const u32x4*)(Kf + ((size_t)head * MT + row0_ + (tid >> 3)) * HD + (tid & 7) * 8); \
        vreg = *(const u32x4*)(VT + (size_t)(head * HD + (tid >> 3)) * MT + row0_ + (tid & 7) * 8); } while (0)
#define NA_STORE(buf) do { *(LAS u32x4*)(lds + (buf) * KBUF + (tid >> 3) * KSTR + (tid & 7) * 16) = kreg; *(LAS u32x4*)(lds + 2 * KBUF + (buf) * VBUF + (tid >> 3) * VSTR + (tid & 7) * 16) = vreg; } while (0)
        __syncthreads();
        NA_LOAD(0); NA_STORE(0);
        for (int i = tid; i < 15 * 31; i += NTHR) rpbL[64 + i] = rpb[head * (15 * 31) + i] * LOG2E;
        __syncthreads();
        float mrun = -INFINITY, lsum = 0.f;
        f32x16 o[2];
#pragma unroll
        for (int d = 0; d < 2; ++d)
#pragma unroll
            for (int i = 0; i < 16; ++i) o[d][i] = 0.f;
#define NA_BLOCK(koff, LOCAL) do { \
        f32x16 s_; \
        _Pragma("unroll") for (int i = 0; i < 16; ++i) s_[i] = 0.f; \
        _Pragma("unroll") for (int ks = 0; ks < 4; ++ks) { const bf16x8 a_ = *(const LAS bf16x8*)(kb_ + ((koff) + r) * KSTR + (16 * ks + 8 * hh) * 2); s_ = __builtin_amdgcn_mfma_f32_32x32x16_bf16(a_, qf[ks], s_, 0, 0, 0); } \
        if (LOCAL) { const bool rowok_ = (rr_ >= rs) && (rr_ < rs + 8); const LAS float* bp_ = rpbL + 64 + (rr_ - rq + 7) * 31 + dcb; \
            _Pragma("unroll") for (int i = 0; i < 16; ++i) { const float bias_ = bp_[(i & 3) + 8 * (i >> 2)]; s_[i] = (rowok_ && ((vmask >> i) & 1u)) ? s_[i] + bias_ : -INFINITY; } } \
        float mx_ = s_[0]; \
        _Pragma("unroll") for (int i = 1; i < 16; ++i) mx_ = fmaxf(mx_, s_[i]); \
        mx_ = fmaxf(mx_, __shfl_xor(mx_, 32)); \
        const float mnew_ = fmaxf(mrun, mx_), msafe_ = (mnew_ == -INFINITY) ? 0.f : mnew_, alpha_ = __builtin_amdgcn_exp2f(mrun - msafe_); mrun = mnew_; \
        float ps_ = 0.f; \
        _Pragma("unroll") for (int i = 0; i < 16; ++i) { s_[i] = __builtin_amdgcn_exp2f(s_[i] - msafe_); ps_ += s_[i]; } \
        lsum = lsum * alpha_ + ps_; \
        _Pragma("unroll") for (int d = 0; d < 2; ++d) _Pragma("unroll") for (int i = 0; i < 16; ++i) o[d][i] *= alpha_; \
        _Pragma("unroll") for (int sx = 0; sx < 2; ++sx) { \
            u32x4 pw_; pw_.x = pk2(s_[8 * sx + 0], s_[8 * sx + 1]); pw_.y = pk2(s_[8 * sx + 2], s_[8 * sx + 3]); pw_.z = pk2(s_[8 * sx + 4], s_[8 * sx + 5]); pw_.w = pk2(s_[8 * sx + 6], s_[8 * sx + 7]); \
            const bf16x8 pb_ = __builtin_bit_cast(bf16x8, pw_); \
            _Pragma("unroll") for (int d = 0; d < 2; ++d) { const LAS unsigned char* vp_ = vb_ + (32 * d + r) * VSTR + ((koff) + 16 * sx + 4 * hh) * 2; \
                const u32x2 v0_ = *(const LAS u32x2*)vp_, v1_ = *(const LAS u32x2*)(vp_ + 16); u32x4 vw_; vw_.x = v0_.x; vw_.y = v0_.y; vw_.z = v1_.x; vw_.w = v1_.y; \
                o[d] = __builtin_amdgcn_mfma_f32_32x32x16_bf16(__builtin_bit_cast(bf16x8, vw_), pb_, o[d], 0, 0, 0); } } } while (0)
        for (int t = 0; t < NT; ++t) {
            const int cur = t & 1;
            if (t + 1 < NT) NA_LOAD(t + 1);
            const LAS unsigned char* kb_ = lds + cur * KBUF; const LAS unsigned char* vb_ = lds + 2 * KBUF + cur * VBUF;
            const int rr_ = rlo + t;
            if (t < nloc) { if (rr_ >= wlo && rr_ <= whi) NA_BLOCK(kc0, true); }
            else { NA_BLOCK(0, false); NA_BLOCK(32, false); }
            if (t + 1 < NT) NA_STORE(cur ^ 1);
            __syncthreads();
        }
        const float ltot = lsum + __shfl_xor(lsum, 32), inv = 1.f / ltot;
        bf16_t* orow = O + (size_t)qrow * (H * HD) + head * HD;
#pragma unroll
        for (int d = 0; d < 2; ++d)
#pragma unroll
            for (int g = 0; g < 4; ++g) { u32x2 w; w.x = pk2(o[d][4 * g] * inv, o[d][4 * g + 1] * inv); w.y = pk2(o[d][4 * g + 2] * inv, o[d][4 * g + 3] * inv);
                *(u32x2*)(orow + 32 * d + 8 * g + 4 * hh) = w; }
#undef NA_ROW0
#undef NA_LOAD
#undef NA_STORE
#undef NA_BLOCK
    }
}

__device__ __forceinline__ int swap23(int r) { return (r & ~12) | ((r & 4) << 1) | ((r & 8) >> 1); }
struct MlaOff { int ko1[8], ko2[4], vo[4]; };
constexpr int MLA_K1 = 0, MLA_K2 = 49152, MLA_V = 73728;
template <int SLOT, int KB> __device__ __forceinline__ void mla_s1(f32x16& sd, const f32x16& cinit, LAS unsigned char* lds, const MlaOff& F, const bf16x8 (&qf)[12]) {
    { const bf16x8 a = *(const LAS bf16x8*)(lds + F.ko1[0] + (SLOT * 16384 + KB * 8192)); sd = __builtin_amdgcn_mfma_f32_32x32x16_bf16(a, qf[0], cinit, 0, 0, 0); }
#pragma unroll
    for (int ks = 1; ks < 8; ++ks) { const bf16x8 a = *(const LAS bf16x8*)(lds + F.ko1[ks] + (SLOT * 16384 + KB * 8192)); sd = __builtin_amdgcn_mfma_f32_32x32x16_bf16(a, qf[ks], sd, 0, 0, 0); }
#pragma unroll
    for (int ks = 0; ks < 4; ++ks) { const bf16x8 a = *(const LAS bf16x8*)(lds + F.ko2[ks] + (SLOT * 8192 + KB * 4096)); sd = __builtin_amdgcn_mfma_f32_32x32x16_bf16(a, qf[8 + ks], sd, 0, 0, 0); }
}
template <int VS, int KB, int NS, int NKB>
__device__ __forceinline__ void mla_step(f32x16& sc, f32x16& sn, f32x16 (&o)[4], f32x16& negm, float& lsum, float& mxc, LAS unsigned char* lds, const MlaOff& F, const bf16x8 (&qf)[12]) {
    if (__any(mxc > 0.f)) { const float dlt = fmaxf(mxc, 0.f), alpha = __builtin_amdgcn_exp2f(-dlt); lsum *= alpha;
#pragma unroll
        for (int i = 0; i < 16; ++i) { negm[i] -= dlt; sc[i] -= dlt; }
#pragma unroll
        for (int d = 0; d < 4; ++d)
#pragma unroll
            for (int i = 0; i < 16; ++i) o[d][i] *= alpha; }
    mla_s1<NS, NKB>(sn, negm, lds, F, qf);
    float ps = 0.f;
#pragma unroll
    for (int i = 0; i < 16; ++i) { sc[i] = __builtin_amdgcn_exp2f(sc[i]); ps += sc[i]; }
    lsum += ps;
#pragma unroll
    for (int sx = 0; sx < 2; ++sx) {
        u32x4 pw; pw.x = pk2(sc[8 * sx + 0], sc[8 * sx + 1]); pw.y = pk2(sc[8 * sx + 2], sc[8 * sx + 3]); pw.z = pk2(sc[8 * sx + 4], sc[8 * sx + 5]); pw.w = pk2(sc[8 * sx + 6], sc[8 * sx + 7]);
        const bf16x8 pb = __builtin_bit_cast(bf16x8, pw);
#pragma unroll
        for (int d = 0; d < 4; ++d) { const bf16x8 va = *(const LAS bf16x8*)(lds + F.vo[2 * KB + sx] + (VS * 16384 + d * 4096)); o[d] = __builtin_amdgcn_mfma_f32_32x32x16_bf16(va, pb, o[d], 0, 0, 0); } }
    float mx = sn[0];
#pragma unroll
    for (int i = 1; i < 16; ++i) mx = fmaxf(mx, sn[i]);
    mxc = fmaxf(mx, __shfl_xor(mx, 32));
}
__device__ __forceinline__ void attn_mla_phase(LAS unsigned char* lds, const bf16_t* __restrict__ Q, const bf16_t* __restrict__ Kf, const bf16_t* __restrict__ VT, bf16_t* __restrict__ O) {
    constexpr int H = 8, DQK = 192, DV = 128;
    const int tid = opaque_tid(), wave = __builtin_amdgcn_readfirstlane(tid >> 6), lane = tid & 63, r = lane & 31, hh = lane >> 5;
    unsigned goff[5], lbase[5], lstr[5]; bool isv[5];
#pragma unroll
    for (int i = 0; i < 5; ++i) {
        const int j = wave * 5 + i;
        if (j < 16) { const int q = j * 64 + lane, key = q >> 4, c = (q & 15) ^ (key & 15); goff[i] = key * DQK + c * 8; lbase[i] = MLA_K1 + j * 1024; lstr[i] = 16384; isv[i] = false; }
        else if (j < 24) { const int q = (j - 16) * 64 + lane, row = q >> 4, cc = (q & 15) ^ (row & 15), key = 2 * row + (cc >> 3); goff[i] = key * DQK + 128 + (cc & 7) * 8; lbase[i] = MLA_K2 + (j - 16) * 1024; lstr[i] = 8192; isv[i] = false; }
        else { const int q = (j - 24) * 64 + lane, row2 = q >> 4, cc = (q & 15) ^ (row2 & 15), dv = 2 * row2 + (cc >> 3); goff[i] = dv * MT + (cc & 7) * 8; lbase[i] = MLA_V + (j - 24) * 1024; lstr[i] = 16384; isv[i] = true; }
    }
    MlaOff F;
    { const int pr = swap23(r), kx = pr & 15, k1row = pr * 256, k2row = (pr >> 1) * 256, k2cb = (pr & 1) * 8, k2x = (pr >> 1) & 15, vrow = (r >> 1) * 256, vcb = (r & 1) * 8, vx = (r >> 1) & 15;
#pragma unroll
      for (int ks = 0; ks < 8; ++ks) F.ko1[ks] = MLA_K1 + k1row + (((2 * ks + hh) ^ kx) << 4);
#pragma unroll
      for (int ks = 0; ks < 4; ++ks) F.ko2[ks] = MLA_K2 + k2row + (((k2cb + 2 * ks + hh) ^ k2x) << 4);
#pragma unroll
      for (int c = 0; c < 4; ++c) F.vo[c] = MLA_V + vrow + (((vcb + 2 * c + hh) ^ vx) << 4); }
    const int nbig = 64 * H, nunits = 65 * H;
    for (int u = blockIdx.x; u < nunits; u += gridDim.x) {
        int head, qb;
        if (u < nbig) { const int b = u & 255, rnd = u >> 8, xcd = b & 7, slot = b >> 3; head = xcd + 8 * (rnd >> 1); qb = 1 + (rnd & 1) * 32 + slot; }
        else { head = u - nbig; qb = 0; }
        const int NT = (qb == 0) ? 4 : 260;
        const int qrow = 256 * qb + 32 * wave + r;
        bf16x8 qf[12];
#pragma unroll
        for (int ks = 0; ks < 12; ++ks) qf[ks] = *(const bf16x8*)(Q + ((size_t)head * MT + qrow) * DQK + 16 * ks + 8 * hh);
        const bf16_t* kbase = Kf + (size_t)head * MT * DQK; const bf16_t* vbase = VT + (size_t)head * DV * MT;
#define MLA_ISSUE(s, SL) do { const bf16_t* kb_ = kbase + (size_t)(s) * 64 * DQK; const bf16_t* vb_ = vbase + (size_t)(s) * 64; \
        _Pragma("unroll") for (int i = 0; i < 5; ++i) __builtin_amdgcn_global_load_lds((const unsigned*)((isv[i] ? vb_ : kb_) + goff[i]), (LAS unsigned*)(lds + lbase[i] + (SL) * lstr[i]), 16, 0, 0); } while (0)
#define MLA_WAITBAR() do { asm volatile("s_waitcnt vmcnt(0)" ::: "memory"); __builtin_amdgcn_s_barrier(); asm volatile("" ::: "memory"); } while (0)
#define MLA_TILE(t, SL) do { \
        mla_step<SL, 0, SL, 1>(sA, sB, o, negm, lsum, mxc, lds, F, qf); \
        if ((t) + 2 < NT) MLA_ISSUE((t) + 2, ((SL) + 2) % 3); \
        mla_step<SL, 1, ((SL) + 1) % 3, 0>(sB, sA, o, negm, lsum, mxc, lds, F, qf); \
        MLA_WAITBAR(); } while (0)
        float lsum = 0.f, mxc;
        f32x16 o[4], sA, sB, negm;
#pragma unroll
        for (int d = 0; d < 4; ++d)
#pragma unroll
            for (int i = 0; i < 16; ++i) o[d][i] = 0.f;
        MLA_ISSUE(0, 0); MLA_ISSUE(1, 1);
        MLA_WAITBAR();
        { f32x16 z;
#pragma unroll
          for (int i = 0; i < 16; ++i) z[i] = 0.f;
          mla_s1<0, 0>(sA, z, lds, F, qf);
          float mx_ = sA[0];
#pragma unroll
          for (int i = 1; i < 16; ++i) mx_ = fmaxf(mx_, sA[i]);
          mx_ = fmaxf(mx_, __shfl_xor(mx_, 32));
#pragma unroll
          for (int i = 0; i < 16; ++i) { negm[i] = -mx_; sA[i] -= mx_; }
          mxc = 0.f; }
        int t = 0;
        for (; t + 3 <= NT; t += 3) { MLA_TILE(t, 0); MLA_TILE(t + 1, 1); MLA_TILE(t + 2, 2); }
        if (t < NT) { MLA_TILE(t, 0); if (t + 1 < NT) MLA_TILE(t + 1, 1); }
        const float ltot = lsum + __shfl_xor(lsum, 32), inv = 1.f / ltot;
        bf16_t* orow = O + (size_t)qrow * (H * DV) + head * DV;
#pragma unroll
        for (int d = 0; d < 4; ++d)
#pragma unroll
            for (int g = 0; g < 4; ++g) { u32x2 w; w.x = pk2(o[d][4 * g] * inv, o[d][4 * g + 1] * inv); w.y = pk2(o[d][4 * g + 2] * inv, o[d][4 * g + 3] * inv);
                *(u32x2*)(orow + 32 * d + 8 * g + 4 * hh) = w; }
#undef MLA_ISSUE
#undef MLA_WAITBAR
#undef MLA_TILE
    }
}

struct Args { const float* in[30]; float* out; unsigned char* ws; int ph_lo, ph_hi; };

typedef const __attribute__((address_space(4))) Args* ArgsP;
__device__ __forceinline__ ArgsP get_args() { ArgsP p = (ArgsP)__builtin_amdgcn_kernarg_segment_ptr(); asm volatile("" : "+s"(p)); return p; }
#define WSP(T, off) ((T*)(ws + (off)))

#define PHASE_BEGIN if (ph >= lo && ph < hi) { ArgsP ap = get_args(); unsigned char* ws = ap->ws; (void)ws;
#define PHASE_END   if (ph + 1 < hi) xcd_barrier(bar); } ++ph;
#define P_X WSP(float, WS_X)
#define P_H WSP(bf16_t, WS_H)
#define P_BIG WSP(bf16_t, WS_BIG)
#define P_MIX WSP(bf16_t, WS_MIX)
#define P_QF WSP(bf16_t, WS_QF)
#define P_KF WSP(bf16_t, WS_KF)
#define P_VT WSP(bf16_t, WS_VT)
#define P_MODL (WSP(float, WS_MOD) + (size_t)L * 2 * 9216)
template <int L>
__device__ __forceinline__ void layer_body(const XcdBarrier& bar, LAS unsigned char* lds, int& ph, const int lo, const int hi) {
    constexpr bool CTX_A = (L <= 2);
    constexpr bool CTX_B = (L <= 1);
    constexpr int RB_A = CTX_A ? 0 : CTX, M_A = CTX_A ? MT : SEQ;
    constexpr int RB_B = CTX_B ? 0 : CTX, M_B = CTX_B ? MT : SEQ;
    PHASE_BEGIN for (int rep = 0; rep < REP_NORM; ++rep) norm_phase((L == 0) ? ap->in[2] : P_X, (L == 0) ? ap->in[0] : P_X + (size_t)CTX * D, P_H, P_MODL, 0, 1, RB_A); PHASE_END
    PHASE_BEGIN for (int rep = 0; rep < REP_FFNIN; ++rep) { EpiSwiglu E{P_BIG, DFF, RB_A}; run_gemm(lds, P_H + (size_t)RB_A * D, WSP(bf16_t, WS_WIN) + (size_t)(2 * L) * 5632 * 1024, M_A, 2 * DFF, D, E, 0); } PHASE_END
    PHASE_BEGIN {
        const bf16_t* W = WSP(bf16_t, WS_WOUT) + (size_t)(2 * L) * 1024 * 2816;
        for (int rep = 1; rep < REP_FFNOUT; ++rep) { EpiResid E{P_X, WSP(float, WS_QF), P_MODL + 9216 + 2 * D, 0.5f, CTX, CTX, 0}; run_gemm(lds, P_BIG + (size_t)CTX * DFF, W, SEQ, D, DFF, E, 0); }
        { EpiResid E{(L == 0) ? ap->in[0] : P_X, P_X, P_MODL + 9216 + 2 * D, 0.5f, CTX, 0, (L == 0) ? CTX : 0}; run_gemm(lds, P_BIG + (size_t)CTX * DFF, W, SEQ, D, DFF, E, 0); }
        if (CTX_A) ctx_resid<DFF>(lds, P_BIG, W, (L == 0) ? ap->in[2] : P_X, P_X, P_MODL + 2 * D, 0.5f);
    } PHASE_END
    PHASE_BEGIN for (int rep = 0; rep < REP_NORM; ++rep) norm_phase(P_X, P_X + (size_t)CTX * D, P_H, P_MODL, 3, 4, RB_A); PHASE_END
    if (L == 0) {
        PHASE_BEGIN { EpiStore E{WSP(bf16_t, WS_DQKV), 768, 0}; run_gemm(lds, P_H, WSP(bf16_t, WS_MLA_DQKV), MT, 768, D, E, 0); } PHASE_END
        PHASE_BEGIN mla_na_phase(WSP(bf16_t, WS_DQKV), WSP(bf16_t, WS_CQN), WSP(bf16_t, WS_CKVN), P_KF, ap->in[9], ap->in[12], ap->in[18]); PHASE_END
        PHASE_BEGIN {
            { EpiStore E{P_BIG, 1536, 0}; run_gemm(lds, WSP(bf16_t, WS_CQN), WSP(bf16_t, WS_MLA_UQ), MT, 1536, 384, E, 0); }
            { EpiStore E{P_BIG + (size_t)MT * 1536, 1024, 0}; run_gemm(lds, WSP(bf16_t, WS_CKVN), WSP(bf16_t, WS_MLA_UK), MT, 1024, 256, E, 134); }
            { EpiStore E{P_VT, MT, 0}; run_gemm(lds, WSP(bf16_t, WS_MLA_UVT), WSP(bf16_t, WS_CKVN), 1024, MT, 256, E, 138); }
        } PHASE_END
        PHASE_BEGIN mla_nb_phase(P_BIG, P_BIG + (size_t)MT * 1536, P_QF, P_KF, ap->in[15], ap->in[16], ap->in[17], 0.07216878364870322f * LOG2E); PHASE_END
        PHASE_BEGIN attn_mla_phase(lds, P_QF, P_KF, P_VT, P_MIX); PHASE_END
    } else if (L == 1) {
        PHASE_BEGIN pool_phase(P_H, P_MIX); PHASE_END
    } else if (L == 2) {
        PHASE_BEGIN {
            { EpiNaQK E{P_QF, P_KF, ap->in[23], ap->in[24], 0.125f * LOG2E}; run_gemm(lds, P_H, WSP(bf16_t, WS_NA_QK), MT, 2048, D, E, 0); }
            { EpiStore E{P_VT, MT, 0}; run_gemm(lds, WSP(bf16_t, WS_NA_VT), P_H, 1024, MT, D, E, 8); }
        } PHASE_END
        PHASE_BEGIN attn_na16_phase(lds, P_QF, P_KF, P_VT, P_MIX, ap->in[25]); PHASE_END
    } else {
        PHASE_BEGIN {
            { EpiMulPair E{P_BIG, D, CTX}; run_gemm(lds, P_H + (size_t)CTX * D, WSP(bf16_t, WS_CV_IN), SEQ, 2048, D, E, 0); }
            { EpiStore E{P_BIG + (size_t)MT * D, D, CTX}; run_gemm(lds, P_H + (size_t)CTX * D, WSP(bf16_t, WS_CV_IN) + (size_t)2048 * D, SEQ, D, D, E, 0); }
        } PHASE_END
        PHASE_BEGIN conv_phase(P_BIG, P_BIG + (size_t)MT * D, P_MIX, ap->in[28]); PHASE_END
    }
    PHASE_BEGIN {
        const size_t wo_off = (L == 0) ? WS_MLA_O : (L == 1) ? WS_POOL : (L == 2) ? WS_NA_O : WS_CV_OUT;
        if (L == 1) {
#pragma unroll
            for (int g = 0; g < 4; ++g) { EpiResid E{P_X + g * 256, P_X + g * 256, P_MODL + 9216 + 5 * D + g * 256, 1.0f, CTX, 0, 0};
                run_gemm(lds, P_MIX + ((size_t)g * MT + CTX) * 256, WSP(bf16_t, WS_POOL) + (size_t)g * 65536, SEQ, 256, 256, E, 64 * g); }
            ctx_resid_pool(lds, P_MIX, WSP(bf16_t, WS_POOL), P_X, P_MODL + 5 * D);
        } else {
        { EpiResid E{P_X, P_X, P_MODL + 9216 + 5 * D, 1.0f, CTX, 0, 0}; run_gemm(lds, P_MIX + (size_t)CTX * D, WSP(bf16_t, wo_off), SEQ, D, D, E, 0); }
        if (CTX_B) ctx_resid<D>(lds, P_MIX, WSP(bf16_t, wo_off), P_X, P_X, P_MODL + 5 * D, 1.0f);
        }
    } PHASE_END
    PHASE_BEGIN for (int rep = 0; rep < REP_NORM; ++rep) norm_phase(P_X, P_X + (size_t)CTX * D, P_H, P_MODL, 6, 7, RB_B); PHASE_END
    PHASE_BEGIN for (int rep = 0; rep < REP_FFNIN; ++rep) { EpiSwiglu E{P_BIG, DFF, RB_B}; run_gemm(lds, P_H + (size_t)RB_B * D, WSP(bf16_t, WS_WIN) + (size_t)(2 * L + 1) * 5632 * 1024, M_B, 2 * DFF, D, E, 0); } PHASE_END
    PHASE_BEGIN {
        const bf16_t* W = WSP(bf16_t, WS_WOUT) + (size_t)(2 * L + 1) * 1024 * 2816;
        { EpiResid E{P_X, (L == 3) ? ap->out : P_X, P_MODL + 9216 + 8 * D, 0.5f, CTX, (L == 3) ? CTX : 0, 0}; run_gemm(lds, P_BIG + (size_t)CTX * DFF, W, SEQ, D, DFF, E, 0); }
        if (CTX_B) ctx_resid<DFF>(lds, P_BIG, W, P_X, P_X, P_MODL + 8 * D, 0.5f);
    } if (L < 3 && ph + 1 < hi) xcd_barrier(bar); } ++ph;
}
__global__ void __launch_bounds__(NTHR, 2) fwd_megakernel(Args args_unused) {
    extern __shared__ __attribute__((aligned(16))) unsigned char lds_raw[];
    LAS unsigned char* lds = (LAS unsigned char*)lds_raw;
    cg::grid_group grid = cg::this_grid();
    int lo, hi; unsigned* barw; { ArgsP ap0 = get_args(); lo = ap0->ph_lo; hi = ap0->ph_hi; barw = (unsigned*)(ap0->ws + WS_BAR); }
    if (lo > hi) grid.sync();
    volatile LAS unsigned* bst = (volatile LAS unsigned*)(lds + 131072);
    if (threadIdx.x < 4) bst[threadIdx.x] = 0u;
    __syncthreads();
    const XcdBarrier bar = xcd_barrier_post(barw, bst);
    int ph = 0;

    PHASE_BEGIN
    for (int rep = 0; rep < REP_P0; ++rep) {
        const int tid = opaque_tid(), lane = tid & 63, wave = tid >> 6;
        bf16_t* WIN = WSP(bf16_t, WS_WIN); bf16_t* WOUT = WSP(bf16_t, WS_WOUT); bf16_t* W_DQKV = WSP(bf16_t, WS_MLA_DQKV); bf16_t* W_POOL = WSP(bf16_t, WS_POOL);
        ConvCtx c; c.base = 0; c.gw = blockIdx.x * NWAVE + wave; c.ngw = gridDim.x * NWAVE; c.lane = lane; c.scr = (LAS float*)(lds + wave * 16384);
        for (int lf = 0; lf < 8; ++lf) {
            conv_job(c, ap->in[6] + (size_t)lf * 1024 * 5632, 5632, 1024, 0, 5632, WIN + (size_t)lf * 5632 * 1024, 1024, 0, 0, nullptr, 1);
            conv_job(c, ap->in[7] + (size_t)lf * 2816 * 1024, 1024, 2816, 0, 1024, WOUT + (size_t)lf * 1024 * 2816, 2816, 0, 0, nullptr, 0);
        }
        conv_job(c, ap->in[8], 384, 1024, 0, 384, W_DQKV, 1024, 0, 0, nullptr, 0);
        conv_job(c, ap->in[11], 320, 1024, 0, 320, W_DQKV, 1024, 384, 0, nullptr, 0);
        conv_job(c, ap->in[10], 1536, 384, 0, 1536, WSP(bf16_t, WS_MLA_UQ), 384, 0, 0, nullptr, 0);
        conv_job(c, ap->in[13], 1024, 256, 0, 1024, WSP(bf16_t, WS_MLA_UK), 256, 0, 0, nullptr, 0);
        conv_job(c, ap->in[14], 1024, 256, 0, 1024, WSP(bf16_t, WS_MLA_UVT), 256, 0, 0, nullptr, 0);
        conv_job(c, ap->in[19], 1024, 1024, 0, 1024, WSP(bf16_t, WS_MLA_O), 1024, 0, 0, nullptr, 0);
        for (int g = 0; g < 4; ++g) conv_job(c, ap->in[20] + (size_t)g * 65536, 256, 256, 0, 256, W_POOL + (size_t)g * 65536, 256, 0, 0, ap->in[21] + g * 256, 0);
        conv_job(c, ap->in[22], 3072, 1024, 0, 2048, WSP(bf16_t, WS_NA_QK), 1024, 0, 0, nullptr, 2);
        conv_job(c, ap->in[22], 3072, 1024, 2048, 1024, WSP(bf16_t, WS_NA_VT), 1024, 0, 0, nullptr, 0);
        conv_job(c, ap->in[26], 1024, 1024, 0, 1024, WSP(bf16_t, WS_NA_O), 1024, 0, 0, nullptr, 0);
        conv_job(c, ap->in[27], 3072, 1024, 1024, 2048, WSP(bf16_t, WS_CV_IN), 1024, 0, 0, nullptr, 3);
        conv_job(c, ap->in[27], 3072, 1024, 0, 1024, WSP(bf16_t, WS_CV_IN), 1024, 2048, 0, nullptr, 0);
        conv_job(c, ap->in[29], 1024, 1024, 0, 1024, WSP(bf16_t, WS_CV_OUT), 1024, 0, 0, nullptr, 0);
        const long gt = (long)blockIdx.x * NTHR + tid, nt = (long)gridDim.x * NTHR;
        for (long i = gt; i < 64 * 128; i += nt) *((u32x4*)(W_DQKV + (size_t)704 * 1024) + i) = (u32x4){0u, 0u, 0u, 0u};
        const float* mw = ap->in[4]; const float* cctx = ap->in[3]; const float* clat = ap->in[1]; const float* mb = ap->in[5]; float* MOD = WSP(float, WS_MOD);
        for (int it = blockIdx.x; it < 256; it += gridDim.x) {
            const int l = it >> 6, col0 = (it & 63) * 144, k0 = 128 * wave;
            f32x4 ac = (f32x4){0.f, 0.f, 0.f, 0.f}, al = (f32x4){0.f, 0.f, 0.f, 0.f};
            if (lane < 36) {
                const float* w = mw + ((size_t)l * 1024 + k0) * 9216 + col0 + 4 * lane;
#pragma unroll 8
                for (int k = 0; k < 128; ++k) { const f32x4 wv = *(const f32x4*)(w + (size_t)k * 9216);
                    const float cc = cctx[k0 + k], cl = clat[k0 + k];
                    const float sc = cc / (1.f + __expf(-cc)), sl = cl / (1.f + __expf(-cl));
                    ac += wv * sc; al += wv * sl; }
                LAS float* pp = (LAS float*)(lds + wave * 16384 + 12288);
                *(LAS f32x4*)(pp + 4 * lane) = ac; *(LAS f32x4*)(pp + 144 + 4 * lane) = al;
            }
            __syncthreads();
            if (tid < 288) { const int sidx = tid / 144, c = tid % 144; float a = mb[l * 9216 + col0 + c];
#pragma unroll
                for (int w8 = 0; w8 < 8; ++w8) a += *(const LAS float*)(lds + w8 * 16384 + 12288 + (sidx * 144 + c) * 4);
                MOD[((size_t)l * 2 + sidx) * 9216 + col0 + c] = a; }
            __syncthreads();
        }
    }
    PHASE_END

    layer_body<0>(bar, lds, ph, lo, hi);
    layer_body<1>(bar, lds, ph, lo, hi);
    layer_body<2>(bar, lds, ph, lo, hi);
    layer_body<3>(bar, lds, ph, lo, hi);
}

extern "C" void kernel_launch(void* const* d_in, const int* in_sizes, int n_in, void* d_out, int out_size, void* d_ws, size_t ws_size, hipStream_t stream) {
    static int grid_blocks = 0;
    if (grid_blocks == 0) {
        if (n_in != 30 || out_size != SEQ * D || ws_size < WS_END) { fprintf(stderr, "kernel_launch: unexpected shapes (n_in %d out %d ws %zu need %zu)\n", n_in, out_size, ws_size, (size_t)WS_END); grid_blocks = -1; return; }
        int dev = 0, cus = 0, per_cu = 0;
        hipGetDevice(&dev);
        hipDeviceGetAttribute(&cus, hipDeviceAttributeMultiprocessorCount, dev);
        if (hipFuncSetAttribute((const void*)fwd_megakernel, hipFuncAttributeMaxDynamicSharedMemorySize, LDS_BYTES) != hipSuccess) { fprintf(stderr, "kernel_launch: hipFuncSetAttribute failed\n"); grid_blocks = -1; return; }
        if (hipOccupancyMaxActiveBlocksPerMultiprocessor(&per_cu, (const void*)fwd_megakernel, NTHR, LDS_BYTES) != hipSuccess || per_cu < 1) { fprintf(stderr, "kernel_launch: occupancy query failed (%d)\n", per_cu); per_cu = 1; (void)hipGetLastError(); }
        grid_blocks = cus * 1;
        (void)per_cu;
    }
    if (grid_blocks < 0) return;
    if (hipMemsetAsync((unsigned char*)d_ws + WS_BAR, 0, (size_t)XCD_BAR_WORDS * 4, stream) != hipSuccess) { fprintf(stderr, "kernel_launch: memset of the barrier words failed\n"); return; }
    Args a{};
    for (int i = 0; i < 30; ++i) a.in[i] = (const float*)d_in[i];
    a.out = (float*)d_out; a.ws = (unsigned char*)d_ws; a.ph_lo = 0; a.ph_hi = 1 << 20;
    void* kargs[] = {&a};
    hipError_t e = hipLaunchCooperativeKernel((const void*)fwd_megakernel, dim3(grid_blocks), dim3(NTHR), kargs, LDS_BYTES, stream);
    if (e != hipSuccess) fprintf(stderr, "kernel_launch: cooperative launch failed: %s (grid %d)\n", hipGetErrorString(e), grid_blocks);
}
```

```cpp
#include <hip/hip_runtime.h>
#include <hip/hip_cooperative_groups.h>
#include <cstdio>
#include <cstdint>
namespace cg = cooperative_groups;
__device__ __forceinline__ int opaque_tid() { int t = (int)threadIdx.x; asm volatile("" : "+v"(t)); return t; }
#define LAS __attribute__((address_space(3)))
#define XB_TMO      128
#define XB_XCNT(j)  (256  + 64 * (j))
#define XB_XSUB(j)  (1280 + 64 * (j))
#define XB_XGEN(j)  (2304 + 64 * (j))
#define XB_TOP      3328
#define XB_TOPGEN   3392
#define XCD_BAR_WORDS 3456
#define XB_SPIN_CAP (1u << 18)

__device__ __forceinline__ unsigned xb_ld(unsigned* p)              { return __hip_atomic_load(p, __ATOMIC_RELAXED, __HIP_MEMORY_SCOPE_AGENT); }
__device__ __forceinline__ unsigned xb_add(unsigned* p, unsigned v) { return __hip_atomic_fetch_add(p, v, __ATOMIC_RELAXED, __HIP_MEMORY_SCOPE_AGENT); }
__device__ __forceinline__ unsigned xb_xcc_id() { return (unsigned)__builtin_amdgcn_s_getreg((3 << 11) | 20) & 0xFu; }
#define XB_SPIN(cond, bar) do { unsigned _sp = 0; while (cond) { __builtin_amdgcn_s_sleep(1); \
    if ((++_sp & 255u) == 0u) { if (xb_ld(&(bar)[XB_TMO])) break; if (_sp > XB_SPIN_CAP) { atomicAdd(&(bar)[XB_TMO], 1u); break; } } } } while (0)

struct XcdBarrier {
    unsigned* bar; unsigned x;
    volatile LAS unsigned* st;
};

__device__ __forceinline__ XcdBarrier xcd_barrier_post(unsigned* bar, volatile LAS unsigned* st) {
    XcdBarrier b; b.bar = bar; b.x = xb_xcc_id(); b.st = st;
    if (threadIdx.x == 0) (void)xb_add(&bar[XB_XCNT(b.x)], 1u);
    return b;
}
__device__ __forceinline__ void xcd_barrier_complete(unsigned* bar, unsigned x, unsigned& nloc, unsigned& nx) {
    const unsigned G = gridDim.x * gridDim.y * gridDim.z;
    unsigned sum, cnt, mine, sp = 0u;
    for (;;) {
        sum = 0u; cnt = 0u; mine = 0u;
#pragma unroll
        for (unsigned j = 0; j < 16; ++j) { const unsigned c = xb_ld(&bar[XB_XCNT(j)]); sum += c; cnt += (c > 0u) ? 1u : 0u; mine = (j == x) ? c : mine; }
        if (sum == G) break;
        __builtin_amdgcn_s_sleep(1);
        if ((++sp & 255u) == 0u) { if (xb_ld(&bar[XB_TMO])) break; if (sp > XB_SPIN_CAP) { atomicAdd(&bar[XB_TMO], 1u); break; } }
    }
    nloc = mine > 0u ? mine : 1u; nx = cnt > 0u ? cnt : 1u;
}

__device__ __forceinline__ void xcd_barrier(const XcdBarrier& b) {
    asm volatile("s_waitcnt vmcnt(0)" ::: "memory");
    __syncthreads();
    if (threadIdx.x == 0) {
        unsigned* bar = b.bar;
        __builtin_amdgcn_s_waitcnt(0);
        unsigned nloc = b.st[0], nx = b.st[1];
        if (nloc == 0u) { xcd_barrier_complete(bar, b.x, nloc, nx); b.st[0] = nloc; b.st[1] = nx; }
        const unsigned old = xb_add(&bar[XB_XSUB(b.x)], 1u);
        const unsigned gen = old / nloc;
        if (old + 1u == (gen + 1u) * nloc) {
            __builtin_amdgcn_fence(__ATOMIC_RELEASE, "agent");
            asm volatile("s_waitcnt vmcnt(0)" ::: "memory");
            const unsigned og = xb_add(&bar[XB_TOP], 1u);
            const unsigned tg = og / nx;
            if (og + 1u == (tg + 1u) * nx) xb_add(&bar[XB_TOPGEN], 1u);
            else XB_SPIN(xb_ld(&bar[XB_TOPGEN]) == tg, bar);
            __builtin_amdgcn_fence(__ATOMIC_ACQUIRE, "agent");
            xb_add(&bar[XB_XGEN(b.x)], 1u);
            asm volatile("s_waitcnt vmcnt(0)" ::: "memory");
        } else {
            XB_SPIN(xb_ld(&bar[XB_XGEN(b.x)]) == gen, bar);
            __builtin_amdgcn_fence(__ATOMIC_ACQUIRE, "agent");
            asm volatile("s_waitcnt vmcnt(0)" ::: "memory");
        }
    }
    __syncthreads();
}
namespace pg8 {
#define PG8_LAS __attribute__((address_space(3)))
typedef unsigned short bf16_t;
typedef short bf16x8 __attribute__((ext_vector_type(8)));
typedef float f32x4 __attribute__((ext_vector_type(4)));
typedef unsigned u32x4 __attribute__((ext_vector_type(4)));
constexpr int BM = 256, BK = 64, HALF = 128, HTB = HALF * BK * 2  , STAGE_BYTES = 8 * HTB, NXCD = 8, WGM = 8;

__host__ __device__ __forceinline__ int lds_byte(int r, int c) { const int st = (r >> 4) * 2 + (c >> 5), rr = r & 15, cc = c & 31, ob = rr * 64 + cc * 2; return st * 1024 + (ob ^ (((ob >> 9) & 1) << 5)); }
__host__ __device__ __forceinline__ void stage_rc(int b, int& R, int& C) { const int st = b / 1024, sb = b % 1024, swz = sb ^ (((sb >> 9) & 1) << 5); R = (st >> 1) * 16 + swz / 64; C = (st & 1) * 32 + (swz % 64) / 2; }
__host__ __device__ __forceinline__ int perm32(int rho) { const int n = rho >> 4, i = rho & 15; return 8 * (i >> 2) + 4 * n + (i & 3); }

struct Unit { int pm, pn; };
struct Gemm { const bf16_t* A; const bf16_t* Bt; int M, N, K; };

struct StaticOrder {
    int nM, nN, nwg, G, c;
    __host__ __device__ void init(int M, int N, int G_, int c_) { nM = M / BM; nN = N / BM; nwg = nM * nN; G = G_; c = c_; }
    __host__ __device__ bool next(int i, Unit& u) const {
        const long L = (long)i * G + c; if (L >= nwg) return false;
        int wgid = (int)L; { const int q = nwg / NXCD, r = nwg % NXCD, xcd = wgid % NXCD, off = wgid / NXCD; wgid = (xcd < r ? xcd * (q + 1) : r * (q + 1) + (xcd - r) * q) + off; }
        const int nig = WGM * nN, gid = wgid / nig, fm = gid * WGM, gsz = (nM - fm) < WGM ? (nM - fm) : WGM;
        u.pm = fm + ((wgid % nig) % gsz); u.pn = (wgid % nig) / gsz; return true;
    }
    __device__ __forceinline__ void a_ready(const Unit&) const {}
    __device__ __forceinline__ void done(const Unit&) const {}
};
__device__ __forceinline__ unsigned cvt_pk_bf16(float lo, float hi) { unsigned r; asm volatile("v_cvt_pk_bf16_f32 %0, %1, %2" : "=v"(r) : "v"(lo), "v"(hi)); return r; }
template <class Epi, class Sched, bool ALIGN_EPI = false, bool SP2 = false>
__device__ __forceinline__ void gemm_phase(PG8_LAS unsigned char* lds, const Gemm g, const Sched& S, const Epi& E) {
    const int tid = opaque_tid(), wid = __builtin_amdgcn_readfirstlane(tid >> 6), lane = tid & 63, wr = wid >> 2, wc = wid & 3, fr = lane & 15, fq = lane >> 4;
    const int K = g.K, nt = K / BK;
    unsigned voffA[2], voffB[2];
#pragma unroll
    for (int i = 0; i < 2; ++i) { int R, C; stage_rc(tid * 16 + i * 8192, R, C); const int Rb = Epi::PERM ? ((R & ~31) + perm32(R & 31)) : R;
        voffA[i] = (unsigned)(R * K + C) * 2u; voffB[i] = (unsigned)(Rb * K + C) * 2u; }
    const size_t kstep = (size_t)(BK * 2);
    const size_t hstep = (size_t)HALF * K * 2;
    const size_t tstep = 2 * hstep;
    const unsigned ldsw = (unsigned)wid * 1024u;
    const int aoff = lds_byte(wr * 64 + fr, fq * 8), boff = lds_byte(wc * 32 + fr, fq * 8);
#define PG8_SA(b, h) (((b) * 2 + (h)) * HTB)
#define PG8_SB(b, h) ((4 + (b) * 2 + (h)) * HTB)
#define PG8_STAGE(bufoff, gbase, voff) do { _Pragma("unroll") for (int _i = 0; _i < 2; ++_i) \
        __builtin_amdgcn_global_load_lds((const unsigned*)((const char*)(gbase) + (voff)[_i]), (PG8_LAS unsigned*)(lds + (bufoff) + ldsw + _i * 8192), 16, 0, 0); } while (0)
#define PG8_LDA(dst, b, h) do { _Pragma("unroll") for (int m = 0; m < 4; ++m) _Pragma("unroll") for (int k = 0; k < 2; ++k) dst[m][k] = *(const PG8_LAS bf16x8*)(lds + PG8_SA(b, h) + aoff + m * 2048 + k * 1024); } while (0)
#define PG8_LDB(dst, b, h) do { _Pragma("unroll") for (int n = 0; n < 2; ++n) _Pragma("unroll") for (int k = 0; k < 2; ++k) dst[n][k] = *(const PG8_LAS bf16x8*)(lds + PG8_SB(b, h) + boff + n * 2048 + k * 1024); } while (0)
#define PG8_MMA(ai, bj, At, Bt) do { __builtin_amdgcn_s_setprio(1); _Pragma("unroll") for (int m = 0; m < 4; ++m) _Pragma("unroll") for (int n = 0; n < 2; ++n) _Pragma("unroll") for (int k = 0; k < 2; ++k) \
        acc[ai][bj][m][n] = __builtin_amdgcn_mfma_f32_16x16x32_bf16(Bt[n][k], At[m][k], acc[ai][bj][m][n], 0, 0, 0); __builtin_amdgcn_s_setprio(0); } while (0)
#define PG8_WAIT_V(n) asm volatile("s_waitcnt vmcnt(" #n ")" ::: "memory")
#define PG8_WAIT_L(n) asm volatile("s_waitcnt lgkmcnt(" #n ")" ::: "memory")
#define PG8_BAR __builtin_amdgcn_s_barrier()
#define PG8_SCHED __builtin_amdgcn_sched_barrier(0)
    Unit cur, nxt; int ui = 0;
    if (!S.next(0, cur)) return;
    f32x4 acc[2][2][4][2];
#pragma unroll
    for (int a = 0; a < 2; ++a)
#pragma unroll
        for (int b = 0; b < 2; ++b)
#pragma unroll
            for (int m = 0; m < 4; ++m)
#pragma unroll
                for (int n = 0; n < 2; ++n) acc[a][b][m][n] = (f32x4){0.f, 0.f, 0.f, 0.f};
    bf16x8 At[4][2], B0[2][2], B1[2][2];
    const char* cA = (const char*)g.A + (size_t)cur.pm * tstep; const char* cB = (const char*)g.Bt + (size_t)cur.pn * tstep;
    S.a_ready(cur);
    if constexpr (SP2) {
        PG8_STAGE(PG8_SB(0, 0), cB, voffB); PG8_STAGE(PG8_SB(0, 1), cB + hstep, voffB); PG8_STAGE(PG8_SA(0, 0), cA, voffA); PG8_STAGE(PG8_SA(0, 1), cA + hstep, voffA);
        if (wr == 1) PG8_BAR;
        PG8_WAIT_V(2); PG8_BAR;
        PG8_STAGE(PG8_SB(1, 0), cB + kstep, voffB); PG8_STAGE(PG8_SA(1, 0), cA + kstep, voffA); PG8_STAGE(PG8_SB(1, 1), cB + hstep + kstep, voffB);
        PG8_WAIT_V(6); PG8_BAR;
    } else {
        PG8_STAGE(PG8_SB(0, 0), cB, voffB); PG8_STAGE(PG8_SA(0, 0), cA, voffA); PG8_STAGE(PG8_SB(0, 1), cB + hstep, voffB); PG8_STAGE(PG8_SA(0, 1), cA + hstep, voffA);
        if (wr == 1) PG8_BAR;
        PG8_WAIT_V(4); PG8_BAR;
        PG8_STAGE(PG8_SB(1, 0), cB + kstep, voffB); PG8_STAGE(PG8_SA(1, 0), cA + kstep, voffA); PG8_STAGE(PG8_SB(1, 1), cB + hstep + kstep, voffB);
        PG8_WAIT_V(6); PG8_BAR;
    }
    for (;;) {
        const bool has_next = S.next(ui + 1, nxt);
        const char* nA = has_next ? (const char*)g.A + (size_t)nxt.pm * tstep : cA; const char* nB = has_next ? (const char*)g.Bt + (size_t)nxt.pn * tstep : cB;
        for (int t = 0; t < nt; t += 2) {
            const bool last = (t == nt - 2);
            const char* a1 = cA + (size_t)(t + 1) * kstep;
            const char* a2 = last ? nA : cA + (size_t)(t + 2) * kstep; const char* b2 = last ? nB : cB + (size_t)(t + 2) * kstep;
            const char* a3 = a2 + kstep; const char* b3 = b2 + kstep;
            if (last && has_next) S.a_ready(nxt);
            if constexpr (SP2) {
            PG8_LDB(B0, 0, 0); PG8_LDB(B1, 0, 1); PG8_SCHED; PG8_LDA(At, 0, 0); PG8_STAGE(PG8_SA(1, 1), a1 + hstep, voffA);
            PG8_WAIT_V(8); PG8_WAIT_L(0); PG8_BAR; PG8_MMA(0, 0, At, B0); PG8_MMA(0, 1, At, B1); PG8_BAR; PG8_SCHED;
            PG8_LDA(At, 0, 1); PG8_STAGE(PG8_SB(0, 0), b2, voffB); PG8_STAGE(PG8_SB(0, 1), b2 + hstep, voffB); PG8_STAGE(PG8_SA(0, 0), a2, voffA);
            PG8_WAIT_V(8); PG8_WAIT_L(0); PG8_BAR; PG8_MMA(1, 0, At, B0); PG8_MMA(1, 1, At, B1); PG8_BAR; PG8_SCHED;
            PG8_LDB(B0, 1, 0); PG8_LDB(B1, 1, 1); PG8_SCHED; PG8_LDA(At, 1, 0); PG8_STAGE(PG8_SA(0, 1), a2 + hstep, voffA);
            PG8_WAIT_V(8); PG8_WAIT_L(0); PG8_BAR; PG8_MMA(0, 0, At, B0); PG8_MMA(0, 1, At, B1); PG8_BAR; PG8_SCHED;
            PG8_LDA(At, 1, 1); PG8_STAGE(PG8_SB(1, 0), b3, voffB); PG8_STAGE(PG8_SB(1, 1), b3 + hstep, voffB); PG8_STAGE(PG8_SA(1, 0), a3, voffA);
            PG8_WAIT_V(8); PG8_WAIT_L(0); PG8_BAR; PG8_MMA(1, 0, At, B0); PG8_MMA(1, 1, At, B1); PG8_BAR; PG8_SCHED;
            } else {
            PG8_LDB(B0, 0, 0); PG8_SCHED; PG8_LDA(At, 0, 0); PG8_STAGE(PG8_SA(1, 1), a1 + hstep, voffA);
            PG8_WAIT_L(8); PG8_BAR; PG8_WAIT_L(0); PG8_MMA(0, 0, At, B0); PG8_BAR; PG8_SCHED;
            PG8_LDB(B1, 0, 1); PG8_STAGE(PG8_SB(0, 0), b2, voffB);
            PG8_BAR; PG8_WAIT_L(0); PG8_MMA(0, 1, At, B1); PG8_BAR;
            PG8_LDA(At, 0, 1); PG8_STAGE(PG8_SA(0, 0), a2, voffA);
            PG8_BAR; PG8_WAIT_L(0); PG8_MMA(1, 0, At, B0); PG8_BAR; PG8_SCHED;
            PG8_STAGE(PG8_SB(0, 1), b2 + hstep, voffB);
            PG8_WAIT_V(6); PG8_BAR; PG8_MMA(1, 1, At, B1); PG8_BAR;
            PG8_LDB(B0, 1, 0); PG8_SCHED; PG8_LDA(At, 1, 0); PG8_STAGE(PG8_SA(0, 1), a2 + hstep, voffA);
            PG8_WAIT_L(8); PG8_BAR; PG8_WAIT_L(0); PG8_MMA(0, 0, At, B0); PG8_BAR; PG8_SCHED;
            PG8_LDB(B1, 1, 1); PG8_STAGE(PG8_SB(1, 0), b3, voffB);
            PG8_BAR; PG8_WAIT_L(0); PG8_MMA(0, 1, At, B1); PG8_BAR;
            PG8_LDA(At, 1, 1); PG8_STAGE(PG8_SA(1, 0), a3, voffA);
            PG8_BAR; PG8_WAIT_L(0); PG8_MMA(1, 0, At, B0); PG8_BAR; PG8_SCHED;
            PG8_STAGE(PG8_SB(1, 1), b3 + hstep, voffB);
            PG8_WAIT_V(6); PG8_BAR; PG8_MMA(1, 1, At, B1); PG8_BAR;
            }
        }
        if constexpr (ALIGN_EPI) { if (wr == 0) PG8_BAR; }
        if constexpr (!Epi::AFTER_DRAIN) { E(acc, cur, wr, wc, fr, fq); S.done(cur); }
        if (!has_next) break;
#pragma unroll
        for (int a = 0; a < 2; ++a)
#pragma unroll
            for (int b = 0; b < 2; ++b)
#pragma unroll
                for (int m = 0; m < 4; ++m)
#pragma unroll
                    for (int n = 0; n < 2; ++n) acc[a][b][m][n] = (f32x4){0.f, 0.f, 0.f, 0.f};
        cur = nxt; cA = nA; cB = nB; ++ui;
        if constexpr (ALIGN_EPI) { if (wr == 1) PG8_BAR; }
    }
    PG8_WAIT_V(0);
    if constexpr (!ALIGN_EPI) { if (wr == 0) PG8_BAR; }
    PG8_BAR;
    if constexpr (Epi::AFTER_DRAIN) { E.fused(acc, cur, wr, wc, fr, fq, lds, wid, lane); S.done(cur); }
#undef PG8_SA
#undef PG8_SB
#undef PG8_STAGE
#undef PG8_LDA
#undef PG8_LDB
#undef PG8_MMA
#undef PG8_WAIT_V
#undef PG8_WAIT_L
#undef PG8_BAR
#undef PG8_SCHED
}
}

using pg8::bf16_t; using pg8::bf16x8; using pg8::f32x4; using pg8::u32x4; using pg8::Unit;
typedef float f32x16 __attribute__((ext_vector_type(16)));
typedef unsigned u32x2 __attribute__((ext_vector_type(2)));
typedef __bf16 bf16v2 __attribute__((ext_vector_type(2)));
typedef float f32v2 __attribute__((ext_vector_type(2)));
typedef short s16x4 __attribute__((ext_vector_type(4)));

constexpr int SEQ = 16384, CTX = 256, MT = SEQ + CTX, D = 1024, DFF = 2816;
constexpr int NTHR = 512, NWAVE = 8;
constexpr int REP_NORM = 1, REP_FFNIN = 1, REP_FFNOUT = 1, REP_P0 = 1;
constexpr int LDS_BYTES = 131072 + 256;
constexpr float EPS = 1e-6f;
constexpr float LOG2E = 1.4426950408889634f;

__device__ __forceinline__ unsigned pk2(float a, float b) { f32v2 v = {a, b}; return __builtin_bit_cast(unsigned, __builtin_convertvector(v, bf16v2)); }
__device__ __forceinline__ float bf_lo(unsigned u) { return __uint_as_float(u << 16); }
__device__ __forceinline__ float bf_hi(unsigned u) { return __uint_as_float(u & 0xffff0000u); }
__device__ __forceinline__ float bf1(bf16_t h) { return __uint_as_float(((unsigned)h) << 16); }
__device__ __forceinline__ bf16_t f2bf(float f) { return (bf16_t)(pk2(f, 0.f) & 0xffffu); }
__device__ __forceinline__ float wave_sum(float v) {
#pragma unroll
    for (int o = 1; o < 64; o <<= 1) v += __shfl_xor(v, o);
    return v;
}
#define LDS_WAIT() asm volatile("s_waitcnt lgkmcnt(0)" ::: "memory")

constexpr size_t al256(size_t x) { return (x + 255) & ~(size_t)255; }
constexpr size_t WS_X = 0;
constexpr size_t WS_H = WS_X + al256((size_t)MT * D * 4);
constexpr size_t WS_BIG = WS_H + al256((size_t)MT * D * 2);
constexpr size_t WS_MIX = WS_BIG + al256((size_t)MT * 3072 * 2);
constexpr size_t WS_DQKV = WS_MIX + al256((size_t)MT * D * 2);
constexpr size_t WS_CQN = WS_DQKV + al256((size_t)MT * 768 * 2);
constexpr size_t WS_CKVN = WS_CQN + al256((size_t)MT * 384 * 2);
constexpr size_t WS_QF = WS_CKVN + al256((size_t)MT * 256 * 2);
constexpr size_t WS_KF = WS_QF + al256((size_t)8 * MT * 192 * 2);
constexpr size_t WS_VT = WS_KF + al256((size_t)8 * MT * 192 * 2);
constexpr size_t WS_MODP = WS_VT + al256((size_t)1024 * MT * 2);
constexpr size_t WS_MOD = WS_MODP + al256((size_t)4 * 32 * 2 * 9216 * 4);
constexpr size_t WS_WIN = WS_MOD + al256((size_t)4 * 2 * 9216 * 4);
constexpr size_t WS_WOUT = WS_WIN + al256((size_t)8 * 5632 * 1024 * 2);
constexpr size_t WS_MLA_DQKV = WS_WOUT + al256((size_t)8 * 1024 * 2816 * 2);
constexpr size_t WS_MLA_UQ = WS_MLA_DQKV + al256((size_t)768 * 1024 * 2);
constexpr size_t WS_MLA_UK = WS_MLA_UQ + al256((size_t)1536 * 384 * 2);
constexpr size_t WS_MLA_UVT = WS_MLA_UK + al256((size_t)1024 * 256 * 2);
constexpr size_t WS_MLA_O = WS_MLA_UVT + al256((size_t)1024 * 256 * 2);
constexpr size_t WS_POOL = WS_MLA_O + al256((size_t)1024 * 1024 * 2);
constexpr size_t WS_NA_QK = WS_POOL + al256((size_t)1024 * 1024 * 2);
constexpr size_t WS_NA_VT = WS_NA_QK + al256((size_t)2048 * 1024 * 2);
constexpr size_t WS_NA_O = WS_NA_VT + al256((size_t)1024 * 1024 * 2);
constexpr size_t WS_CV_IN = WS_NA_O + al256((size_t)1024 * 1024 * 2);
constexpr size_t WS_CV_OUT = WS_CV_IN + al256((size_t)3072 * 1024 * 2);
constexpr size_t WS_BAR = WS_CV_OUT + al256((size_t)1024 * 1024 * 2);
constexpr size_t WS_END = WS_BAR + al256((size_t)XCD_BAR_WORDS * 4);

struct EpiStore {
    static constexpr bool PERM = true, AFTER_DRAIN = false;
    bf16_t* O; int ldc; int row_base;
    __device__ __forceinline__ void operator()(const f32x4 (&acc)[2][2][4][2], const Unit& u, int wr, int wc, int fr, int fq) const {
        const int row0 = row_base + u.pm * 256 + wr * 64 + fr, col0 = u.pn * 256 + wc * 32 + 8 * fq;
#pragma unroll
        for (int ai = 0; ai < 2; ++ai)
#pragma unroll
            for (int m = 0; m < 4; ++m) { bf16_t* rowp = O + (size_t)(row0 + ai * 128 + m * 16) * ldc + col0;
#pragma unroll
                for (int bj = 0; bj < 2; ++bj) { const f32x4 v0 = acc[ai][bj][m][0], v1 = acc[ai][bj][m][1];
                    u32x4 w; w.x = pk2(v0[0], v0[1]); w.y = pk2(v0[2], v0[3]); w.z = pk2(v1[0], v1[1]); w.w = pk2(v1[2], v1[3]);
                    *(u32x4*)(rowp + bj * 128) = w; } }
    }
};
__device__ __forceinline__ float silu_f(float g) { return g * __builtin_amdgcn_rcpf(1.f + __expf(-g)); }
struct EpiSwiglu {
    static constexpr bool PERM = true, AFTER_DRAIN = false;
    bf16_t* O; int ldc; int row_base;
    __device__ __forceinline__ void operator()(const f32x4 (&acc)[2][2][4][2], const Unit& u, int wr, int wc, int fr, int fq) const {
        const int row0 = row_base + u.pm * 256 + wr * 64 + fr, col0 = u.pn * 128 + wc * 32 + 8 * fq;
#pragma unroll
        for (int ai = 0; ai < 2; ++ai)
#pragma unroll
            for (int m = 0; m < 4; ++m) { bf16_t* rowp = O + (size_t)(row0 + ai * 128 + m * 16) * ldc + col0;
                const f32x4 g0 = acc[ai][0][m][0], g1 = acc[ai][0][m][1], u0 = acc[ai][1][m][0], u1 = acc[ai][1][m][1];
                u32x4 w;
                w.x = pk2(silu_f(g0[0]) * u0[0], silu_f(g0[1]) * u0[1]); w.y = pk2(silu_f(g0[2]) * u0[2], silu_f(g0[3]) * u0[3]);
                w.z = pk2(silu_f(g1[0]) * u1[0], silu_f(g1[1]) * u1[1]); w.w = pk2(silu_f(g1[2]) * u1[2], silu_f(g1[3]) * u1[3]);
                *(u32x4*)rowp = w; }
    }
};
struct EpiResid {
    static constexpr bool PERM = true, AFTER_DRAIN = false;
    const float* xin; float* xout; const float* gate; float coef; int row_base; int out_row_off; int in_row_off;
    __device__ __forceinline__ void operator()(const f32x4 (&acc)[2][2][4][2], const Unit& u, int wr, int wc, int fr, int fq) const {
        const int row0 = row_base + u.pm * 256 + wr * 64 + fr, col0 = u.pn * 256 + wc * 32 + 8 * fq;
        f32x4 gv[2][2];
#pragma unroll
        for (int bj = 0; bj < 2; ++bj)
#pragma unroll
            for (int n = 0; n < 2; ++n) gv[bj][n] = *(const f32x4*)(gate + col0 + bj * 128 + 4 * n) * coef;
#pragma unroll
        for (int ai = 0; ai < 2; ++ai)
#pragma unroll
            for (int m = 0; m < 4; ++m) { const int row = row0 + ai * 128 + m * 16;
                const float* xi = xin + (size_t)(row - in_row_off) * D + col0; float* xo = xout + (size_t)(row - out_row_off) * D + col0;
#pragma unroll
                for (int bj = 0; bj < 2; ++bj)
#pragma unroll
                    for (int n = 0; n < 2; ++n) { const f32x4 xv = *(const f32x4*)(xi + bj * 128 + 4 * n);
                        *(f32x4*)(xo + bj * 128 + 4 * n) = xv + gv[bj][n] * acc[ai][bj][m][n]; } }
    }
};
struct EpiNaQK {
    static constexpr bool PERM = true, AFTER_DRAIN = false;
    bf16_t* QN; bf16_t* KN; const float* g_q; const float* g_k; float qscale;
    __device__ __forceinline__ void operator()(const f32x4 (&acc)[2][2][4][2], const Unit& u, int wr, int wc, int fr, int fq) const {
        const int hh = u.pn * 4 + wc; const bool isq = hh < 16; const int h = hh & 15;
        const float* g = isq ? g_q : g_k; const float sc = isq ? qscale : 1.f;
        bf16_t* outb = (isq ? QN : KN) + (size_t)h * MT * 64;
        f32x4 gv[2][2];
#pragma unroll
        for (int bj = 0; bj < 2; ++bj)
#pragma unroll
            for (int n = 0; n < 2; ++n) gv[bj][n] = *(const f32x4*)(g + 32 * bj + 8 * fq + 4 * n) * sc;
        const int row0 = u.pm * 256 + wr * 64 + fr;
#pragma unroll
        for (int ai = 0; ai < 2; ++ai)
#pragma unroll
            for (int m = 0; m < 4; ++m) { const int row = row0 + ai * 128 + m * 16;
                float ss = 0.f;
#pragma unroll
                for (int bj = 0; bj < 2; ++bj)
#pragma unroll
                    for (int n = 0; n < 2; ++n) { const f32x4 v = acc[ai][bj][m][n]; ss += (v[0] * v[0] + v[1] * v[1]) + (v[2] * v[2] + v[3] * v[3]); }
                ss += __shfl_xor(ss, 16); ss += __shfl_xor(ss, 32);
                const float rinv = rsqrtf(ss * (1.f / 64.f) + EPS);
#pragma unroll
                for (int bj = 0; bj < 2; ++bj) { const f32x4 v0 = acc[ai][bj][m][0] * gv[bj][0] * rinv, v1 = acc[ai][bj][m][1] * gv[bj][1] * rinv;
                    u32x4 w; w.x = pk2(v0[0], v0[1]); w.y = pk2(v0[2], v0[3]); w.z = pk2(v1[0], v1[1]); w.w = pk2(v1[2], v1[3]);
                    *(u32x4*)(outb + (size_t)row * 64 + 32 * bj + 8 * fq) = w; } }
    }
};
struct EpiMulPair {
    static constexpr bool PERM = true, AFTER_DRAIN = false;
    bf16_t* O; int ldc; int row_base;
    __device__ __forceinline__ void operator()(const f32x4 (&acc)[2][2][4][2], const Unit& u, int wr, int wc, int fr, int fq) const {
        const int row0 = row_base + u.pm * 256 + wr * 64 + fr, col0 = u.pn * 128 + wc * 32 + 8 * fq;
#pragma unroll
        for (int ai = 0; ai < 2; ++ai)
#pragma unroll
            for (int m = 0; m < 4; ++m) { bf16_t* rowp = O + (size_t)(row0 + ai * 128 + m * 16) * ldc + col0;
                const f32x4 p0 = acc[ai][0][m][0] * acc[ai][1][m][0], p1 = acc[ai][0][m][1] * acc[ai][1][m][1];
                u32x4 w; w.x = pk2(p0[0], p0[1]); w.y = pk2(p0[2], p0[3]); w.z = pk2(p1[0], p1[1]); w.w = pk2(p1[2], p1[3]);
                *(u32x4*)rowp = w; }
    }
};
template <class Epi>
__device__ __forceinline__ void run_gemm(LAS unsigned char* lds, const bf16_t* A, const bf16_t* Bt, int M, int N, int K, const Epi& E, int rot) {
    pg8::Gemm g{A, Bt, M, N, K}; pg8::StaticOrder S; S.init(M, N, (int)gridDim.x, (int)((blockIdx.x + (unsigned)rot) % gridDim.x));
    pg8::gemm_phase<Epi, pg8::StaticOrder, true, true>(lds, g, S, E);
}

template <int K>
__device__ __forceinline__ void ctx_resid(LAS unsigned char* lds, const bf16_t* __restrict__ A, const bf16_t* __restrict__ Bt, const float* Xin, float* X,
                                          const float* __restrict__ gate, float coef) {
    const int tid = opaque_tid(), wave = tid >> 6, lane = tid & 63, fr = lane & 15, fq = lane >> 4;
    LAS float* part = (LAS float*)lds;
    constexpr int kw = K / 8;
    for (int p = blockIdx.x; p < 256; p += gridDim.x) {
        const int rb = p >> 4, cb = p & 15;
        f32x4 acc[4];
#pragma unroll
        for (int j = 0; j < 4; ++j) acc[j] = (f32x4){0.f, 0.f, 0.f, 0.f};
        const bf16_t* ap = A + (size_t)(16 * rb + fr) * K + wave * kw + 8 * fq;
        const bf16_t* bp = Bt + (size_t)(64 * cb + fr) * K + wave * kw + 8 * fq;
        const int erow = tid >> 5, ecol = (tid & 31) * 2; const size_t xo = (size_t)(16 * rb + erow) * D + 64 * cb + ecol;
        f32v2 xv = *(const f32v2*)(Xin + xo); const f32v2 gvv = *(const f32v2*)(gate + 64 * cb + ecol);
        constexpr int NS = kw / 32;
#pragma unroll
        for (int k0 = 0; k0 < NS; k0 += 4) {
            bf16x8 av[4], bv[4][4];
#pragma unroll
            for (int s2 = 0; s2 < 4; ++s2) if (k0 + s2 < NS) { av[s2] = *(const bf16x8*)(ap + 32 * (k0 + s2));
#pragma unroll
                for (int j = 0; j < 4; ++j) bv[s2][j] = *(const bf16x8*)(bp + (size_t)(16 * j) * K + 32 * (k0 + s2)); }
            __builtin_amdgcn_sched_barrier(0);
#pragma unroll
            for (int s2 = 0; s2 < 4; ++s2) if (k0 + s2 < NS) {
#pragma unroll
                for (int j = 0; j < 4; ++j) acc[j] = __builtin_amdgcn_mfma_f32_16x16x32_bf16(bv[s2][j], av[s2], acc[j], 0, 0, 0); }
            __builtin_amdgcn_sched_barrier(0);
        }
#pragma unroll
        for (int j = 0; j < 4; ++j) *(LAS f32x4*)(part + (wave * 16 + fr) * 64 + 16 * j + 4 * fq) = acc[j];
        __syncthreads();
        { float s0 = 0.f, s1 = 0.f;
#pragma unroll
            for (int w = 0; w < 8; ++w) { const f32v2 v = *(const LAS f32v2*)(part + (w * 16 + erow) * 64 + ecol); s0 += v.x; s1 += v.y; }
            xv.x += coef * gvv.x * s0; xv.y += coef * gvv.y * s1; *(f32v2*)(X + xo) = xv; }
        __syncthreads();
    }
}

__device__ __forceinline__ void ctx_resid_pool(LAS unsigned char* lds, const bf16_t* __restrict__ Yg, const bf16_t* __restrict__ Wg, float* X, const float* __restrict__ gate) {
    const int tid = opaque_tid(), wave = tid >> 6, lane = tid & 63, fr = lane & 15, fq = lane >> 4;
    LAS float* part = (LAS float*)lds;
    for (int p = blockIdx.x; p < 256; p += gridDim.x) {
        const int g = p >> 6, rb = (p >> 2) & 15, cb = p & 3;
        const int erow = tid >> 5, ecol = (tid & 31) * 2; const size_t xo = (size_t)(16 * rb + erow) * D + 256 * g + 64 * cb + ecol;
        f32v2 xv = *(const f32v2*)(X + xo); const f32v2 gvv = *(const f32v2*)(gate + 256 * g + 64 * cb + ecol);
        const bf16x8 a = *(const bf16x8*)(Yg + ((size_t)g * MT + 16 * rb + fr) * 256 + 32 * wave + 8 * fq);
        f32x4 acc[4];
#pragma unroll
        for (int j = 0; j < 4; ++j) { const bf16x8 b = *(const bf16x8*)(Wg + ((size_t)g * 256 + 64 * cb + 16 * j + fr) * 256 + 32 * wave + 8 * fq);
            acc[j] = __builtin_amdgcn_mfma_f32_16x16x32_bf16(b, a, (f32x4){0.f, 0.f, 0.f, 0.f}, 0, 0, 0); }
#pragma unroll
        for (int j = 0; j < 4; ++j) *(LAS f32x4*)(part + (wave * 16 + fr) * 64 + 16 * j + 4 * fq) = acc[j];
        __syncthreads();
        { float s0 = 0.f, s1 = 0.f;
#pragma unroll
            for (int w = 0; w < 8; ++w) { const f32v2 v = *(const LAS f32v2*)(part + (w * 16 + erow) * 64 + ecol); s0 += v.x; s1 += v.y; }
            xv.x += gvv.x * s0; xv.y += gvv.y * s1; *(f32v2*)(X + xo) = xv; }
        __syncthreads();
    }
}

__device__ __forceinline__ void tr_item(const float* __restrict__ W, int ldw, int k0, int sc0, bf16_t* __restrict__ WT, int ldt, int dr0, int dc0,
                                        const float* __restrict__ scale, LAS float* scr, int lane) {
#pragma unroll 16
    for (int i = 0; i < 32; ++i) { const int kk = 2 * i + (lane >> 5); scr[kk * 33 + (lane & 31)] = W[(size_t)(k0 + kk) * ldw + sc0 + (lane & 31)]; }
    LDS_WAIT();
    const int c = lane & 7;
#pragma unroll
    for (int j = 0; j < 4; ++j) { const int n = (lane >> 3) + 8 * j; const LAS float* s = scr + (8 * c) * 33 + n;
        const float sc = scale ? scale[dr0 + n] : 1.f;
        u32x4 o; o.x = pk2(s[0 * 33] * sc, s[1 * 33] * sc); o.y = pk2(s[2 * 33] * sc, s[3 * 33] * sc); o.z = pk2(s[4 * 33] * sc, s[5 * 33] * sc); o.w = pk2(s[6 * 33] * sc, s[7 * 33] * sc);
        *(u32x4*)(WT + (size_t)(dr0 + n) * ldt + dc0 + k0 + 8 * c) = o; }
    LDS_WAIT();
}
struct ConvCtx { long base; int gw, ngw, lane; LAS float* scr; };
__device__ __forceinline__ void conv_job(ConvCtx& c, const float* W, int ldw, int K, int sc0, int ncols, bf16_t* WT, int ldt, int dr0, int dc0, const float* scale, int mode) {
    const int nblk = ncols / 32; const long n_items = (long)(K / 64) * nblk;
    long rem = ((long)c.gw - c.base) % c.ngw; if (rem < 0) rem += c.ngw;
    for (long g = c.base + rem; g < c.base + n_items; g += c.ngw) {
        const int it = (int)(g - c.base), kb = it / nblk, nb = it % nblk, n0 = 32 * nb;
        int src_col = sc0 + n0;
        if (mode == 1) { const int pn = n0 >> 8, bj = (n0 >> 7) & 1, j0 = n0 & 127; src_col = bj * DFF + 128 * pn + j0; }
        if (mode == 3) { const int pn = n0 >> 8, bj = (n0 >> 7) & 1, j0 = n0 & 127; src_col = sc0 + bj * 1024 + 128 * pn + j0; }
        if (mode == 2) { const int pn = n0 >> 8, bj = (n0 >> 7) & 1, wcc = (n0 >> 5) & 3; src_col = sc0 + (pn * 4 + wcc) * 64 + 32 * bj; }
        tr_item(W, ldw, 64 * kb, src_col, WT, ldt, dr0 + n0, dc0, scale, c.scr, c.lane);
    }
    c.base += n_items;
}

__device__ __forceinline__ void norm_phase(const float* __restrict__ Xc, const float* __restrict__ Xl, bf16_t* __restrict__ H, const float* __restrict__ modL, int i_shift, int i_scale, int row_begin) {
    const int tid_ = opaque_tid(), lane = tid_ & 63, gw = blockIdx.x * NWAVE + (tid_ >> 6), ngw = gridDim.x * NWAVE;
    for (int row = row_begin + gw; row < MT; row += ngw) {
        const float* mp = modL + (row >= CTX ? 9216 : 0);
        const f32x4* xr = (const f32x4*)(row >= CTX ? Xl + (size_t)(row - CTX) * D : Xc + (size_t)row * D) + lane;
        f32x4 v[4], sh[4], sc[4];
#pragma unroll
        for (int j = 0; j < 4; ++j) { v[j] = xr[64 * j]; sh[j] = *((const f32x4*)(mp + i_shift * D) + lane + 64 * j); sc[j] = *((const f32x4*)(mp + i_scale * D) + lane + 64 * j); }
        __builtin_amdgcn_sched_barrier(0);
        float ss = 0.f;
#pragma unroll
        for (int j = 0; j < 4; ++j) ss += (v[j].x * v[j].x + v[j].y * v[j].y) + (v[j].z * v[j].z + v[j].w * v[j].w);
        const float rinv = rsqrtf(wave_sum(ss) * (1.f / D) + EPS);
        u32x2* o = (u32x2*)(H + (size_t)row * D) + lane;
#pragma unroll
        for (int j = 0; j < 4; ++j) {
            const f32x4 h = v[j] * rinv * (sc[j] + 1.f) + sh[j];
            u32x2 w; w.x = pk2(h.x, h.y); w.y = pk2(h.z, h.w); o[64 * j] = w; }
    }
}

__device__ __forceinline__ float rope_elem(float val, float oth, int e, int t) {
    if (t < 0) return val;
    const int p = e >> 1, fi = p & 15;
    const float freq = __builtin_amdgcn_exp2f(-(float)fi * (13.287712379549449f / 16.f));
    const float pos = (p < 16) ? (float)(t >> 6) : (float)(t & 63);
    const float rev = pos * freq * 0.15915494309189535f, fr_ = rev - floorf(rev);
    const float sn = __builtin_amdgcn_sinf(fr_), cs = __builtin_amdgcn_cosf(fr_);
    return (e & 1) ? (oth * sn + val * cs) : (val * cs - oth * sn);
}

__device__ __forceinline__ void mla_na_phase(const bf16_t* __restrict__ R, bf16_t* __restrict__ CQN, bf16_t* __restrict__ CKVN, bf16_t* __restrict__ KF,
                                             const float* __restrict__ g_dq, const float* __restrict__ g_dkv, const float* __restrict__ g_kr) {
    const int tid_ = opaque_tid(), lane = tid_ & 63, gw = blockIdx.x * NWAVE + (tid_ >> 6), ngw = gridDim.x * NWAVE;
    for (int rowa = gw; rowa < MT; rowa += 2 * ngw) {
        int rows[2] = {rowa, min(rowa + ngw, MT - 1)};
        unsigned q[2][3]; u32x2 kv[2]; float kr[2], ss[2], sk[2], sr[2];
#pragma unroll
        for (int u = 0; u < 2; ++u) { const bf16_t* r = R + (size_t)rows[u] * 768;
#pragma unroll
            for (int j = 0; j < 3; ++j) q[u][j] = *((const unsigned*)r + lane + 64 * j);
            kv[u] = *((const u32x2*)(r + 384) + lane); kr[u] = bf1(r[640 + lane]); }
#pragma unroll
        for (int u = 0; u < 2; ++u) { float s_ = 0.f;
#pragma unroll
            for (int j = 0; j < 3; ++j) { const float a = bf_lo(q[u][j]), b = bf_hi(q[u][j]); s_ += a * a + b * b; }
            ss[u] = s_;
            const float k0 = bf_lo(kv[u].x), k1 = bf_hi(kv[u].x), k2 = bf_lo(kv[u].y), k3 = bf_hi(kv[u].y);
            sk[u] = k0 * k0 + k1 * k1 + k2 * k2 + k3 * k3; sr[u] = kr[u] * kr[u]; }
#pragma unroll
        for (int o = 1; o < 64; o <<= 1)
#pragma unroll
            for (int u = 0; u < 2; ++u) { ss[u] += __shfl_xor(ss[u], o); sk[u] += __shfl_xor(sk[u], o); sr[u] += __shfl_xor(sr[u], o); }
#pragma unroll
        for (int u = 0; u < 2; ++u) { const int row = rows[u];
            const float rq = rsqrtf(ss[u] * (1.f / 384.f) + EPS), rk = rsqrtf(sk[u] * (1.f / 256.f) + EPS), rr = rsqrtf(sr[u] * (1.f / 64.f) + EPS);
#pragma unroll
            for (int j = 0; j < 3; ++j) { const int e = 2 * lane + 128 * j;
                *((unsigned*)(CQN + (size_t)row * 384) + lane + 64 * j) = pk2(bf_lo(q[u][j]) * rq * g_dq[e], bf_hi(q[u][j]) * rq * g_dq[e + 1]); }
            const float k0 = bf_lo(kv[u].x), k1 = bf_hi(kv[u].x), k2 = bf_lo(kv[u].y), k3 = bf_hi(kv[u].y);
            u32x2 w; w.x = pk2(k0 * rk * g_dkv[4 * lane], k1 * rk * g_dkv[4 * lane + 1]); w.y = pk2(k2 * rk * g_dkv[4 * lane + 2], k3 * rk * g_dkv[4 * lane + 3]);
            *((u32x2*)(CKVN + (size_t)row * 256) + lane) = w;
            const float val = kr[u] * rr * g_kr[lane], oth = __shfl_xor(val, 1);
            const bf16_t ko = f2bf(rope_elem(val, oth, lane, row - CTX));
#pragma unroll
            for (int h = 0; h < 8; ++h) KF[((size_t)h * MT + row) * 192 + 128 + lane] = ko; }
    }
}
__device__ __forceinline__ void mla_nb_phase(const bf16_t* __restrict__ QR, const bf16_t* __restrict__ KR, bf16_t* __restrict__ QF, bf16_t* __restrict__ KF,
                                             const float* __restrict__ g_qn, const float* __restrict__ g_qr, const float* __restrict__ g_kn, float qscale) {
    const int tid_ = opaque_tid(), lane = tid_ & 63, gw = blockIdx.x * NWAVE + (tid_ >> 6), ngw = gridDim.x * NWAVE;
    const float gq0 = g_qn[2 * lane], gq1 = g_qn[2 * lane + 1], gk0 = g_kn[2 * lane], gk1 = g_kn[2 * lane + 1], gr = g_qr[lane];
    for (int row = gw; row < MT; row += ngw) {
        unsigned qn[8], kn[8]; float qrv[8], s1[8], s2[8], s3[8];
#pragma unroll
        for (int h = 0; h < 8; ++h) { const bf16_t* q = QR + (size_t)row * 1536 + h * 192;
            qn[h] = *((const unsigned*)q + lane); qrv[h] = bf1(q[128 + lane]); kn[h] = *((const unsigned*)(KR + (size_t)row * 1024 + h * 128) + lane); }
        __builtin_amdgcn_sched_barrier(0);
#pragma unroll
        for (int h = 0; h < 8; ++h) { const float a = bf_lo(qn[h]), b2 = bf_hi(qn[h]), c = bf_lo(kn[h]), d = bf_hi(kn[h]); s1[h] = a * a + b2 * b2; s2[h] = qrv[h] * qrv[h]; s3[h] = c * c + d * d; }
#pragma unroll
        for (int o = 1; o < 64; o <<= 1)
#pragma unroll
            for (int h = 0; h < 8; ++h) { s1[h] += __shfl_xor(s1[h], o); s2[h] += __shfl_xor(s2[h], o); s3[h] += __shfl_xor(s3[h], o); }
#pragma unroll
        for (int h = 0; h < 8; ++h) {
            const float r1 = rsqrtf(s1[h] * (1.f / 128.f) + EPS), r2 = rsqrtf(s2[h] * (1.f / 64.f) + EPS), r3 = rsqrtf(s3[h] * (1.f / 128.f) + EPS);
            bf16_t* qo = QF + ((size_t)h * MT + row) * 192;
            *((unsigned*)qo + lane) = pk2(bf_lo(qn[h]) * r1 * gq0 * qscale, bf_hi(qn[h]) * r1 * gq1 * qscale);
            const float val = qrv[h] * r2 * gr, oth = __shfl_xor(val, 1);
            qo[128 + lane] = f2bf(rope_elem(val, oth, lane, row - CTX) * qscale);
            *((unsigned*)(KF + ((size_t)h * MT + row) * 192) + lane) = pk2(bf_lo(kn[h]) * r3 * gk0, bf_hi(kn[h]) * r3 * gk1);
        }
    }
}
__device__ __forceinline__ void na_norm_phase(const bf16_t* __restrict__ R, bf16_t* __restrict__ QN, bf16_t* __restrict__ KN,
                                              const float* __restrict__ g_q, const float* __restrict__ g_k, float qscale) {
    const int tid_ = opaque_tid(), lane = tid_ & 63, gw = blockIdx.x * NWAVE + (tid_ >> 6), ngw = gridDim.x * NWAVE;
    const int e0 = 8 * (lane & 7);
    for (int row = gw; row < MT; row += ngw) {
#pragma unroll
        for (int j = 0; j < 4; ++j) {
            const u32x4 v = *((const u32x4*)(R + (size_t)row * 2048 + j * 512) + lane);
            float f[8] = {bf_lo(v.x), bf_hi(v.x), bf_lo(v.y), bf_hi(v.y), bf_lo(v.z), bf_hi(v.z), bf_lo(v.w), bf_hi(v.w)};
            float ss = 0.f;
#pragma unroll
            for (int i = 0; i < 8; ++i) ss += f[i] * f[i];
            ss += __shfl_xor(ss, 1); ss += __shfl_xor(ss, 2); ss += __shfl_xor(ss, 4);
            const float rinv = rsqrtf(ss * (1.f / 64.f) + EPS);
            const int seg = j * 8 + (lane >> 3);
            const bool isq = seg < 16; const int h = seg & 15;
            const float* g = isq ? g_q : g_k; const float sc = isq ? rinv * qscale : rinv;
            u32x4 w; w.x = pk2(f[0] * sc * g[e0], f[1] * sc * g[e0 + 1]); w.y = pk2(f[2] * sc * g[e0 + 2], f[3] * sc * g[e0 + 3]);
            w.z = pk2(f[4] * sc * g[e0 + 4], f[5] * sc * g[e0 + 5]); w.w = pk2(f[6] * sc * g[e0 + 6], f[7] * sc * g[e0 + 7]);
            *(u32x4*)((isq ? QN : KN) + ((size_t)h * MT + row) * 64 + e0) = w;
        }
    }
}
template <int G>
__device__ __forceinline__ void pool_group(const bf16_t* __restrict__ H, bf16_t* __restrict__ Y) {
    constexpr int HALF = 1 << G, W = 2 * HALF;
    const long n = (long)MT * 32, stride = (long)gridDim.x * NTHR;
    for (long idx = (long)blockIdx.x * NTHR + opaque_tid(); idx < n; idx += stride) {
        const int row = (int)(idx >> 5), ch = G * 32 + (int)(idx & 31);
        const int base = row >= CTX ? CTX : 0, T = row >= CTX ? SEQ : CTX, ts = row - base;
        const int lo = max(ts - HALF, 0), hi = min(ts + HALF, T);
        u32x4 v[W];
#pragma unroll
        for (int j = 0; j < W; ++j) { const int r = min(max(ts - HALF + j, 0), T - 1); v[j] = *((const u32x4*)(H + (size_t)(base + r) * D) + ch); }
        const u32x4 c = *((const u32x4*)(H + (size_t)row * D) + ch);
        float s[8] = {0, 0, 0, 0, 0, 0, 0, 0};
#pragma unroll
        for (int j = 0; j < W; ++j) { const int r = ts - HALF + j; const float wgt = (r >= lo && r < hi) ? 1.f : 0.f;
            s[0] += wgt * bf_lo(v[j].x); s[1] += wgt * bf_hi(v[j].x); s[2] += wgt * bf_lo(v[j].y); s[3] += wgt * bf_hi(v[j].y);
            s[4] += wgt * bf_lo(v[j].z); s[5] += wgt * bf_hi(v[j].z); s[6] += wgt * bf_lo(v[j].w); s[7] += wgt * bf_hi(v[j].w); }
        const float inv = 1.f / (float)(hi - lo);
        u32x4 w; w.x = pk2(s[0] * inv - bf_lo(c.x), s[1] * inv - bf_hi(c.x)); w.y = pk2(s[2] * inv - bf_lo(c.y), s[3] * inv - bf_hi(c.y));
        w.z = pk2(s[4] * inv - bf_lo(c.z), s[5] * inv - bf_hi(c.z)); w.w = pk2(s[6] * inv - bf_lo(c.w), s[7] * inv - bf_hi(c.w));
        *((u32x4*)(Y + ((size_t)G * MT + row) * 256) + (int)(idx & 31)) = w;
    }
}
__device__ __forceinline__ void pool_phase(const bf16_t* __restrict__ H, bf16_t* __restrict__ Y) {
    pool_group<0>(H, Y); pool_group<1>(H, Y); pool_group<2>(H, Y); pool_group<3>(H, Y);
}
__device__ __forceinline__ void conv_phase(const bf16_t* __restrict__ CU, const bf16_t* __restrict__ Bg, bf16_t* __restrict__ G, const float* __restrict__ cw) {
    const long n = (long)MT * 128, stride = (long)gridDim.x * NTHR;
    for (long idx = (long)CTX * 128 + (long)blockIdx.x * NTHR + opaque_tid(); idx < n; idx += stride) {
        const int row = (int)(idx >> 7), ch = (int)(idx & 127);
        float z[8] = {0, 0, 0, 0, 0, 0, 0, 0};
        u32x4 cv[3]; f32x4 w0v[3], w1v[3];
#pragma unroll
        for (int k = 0; k < 3; ++k) { const int r = min(max(row + k - 1, CTX), MT - 1);
            cv[k] = *((const u32x4*)(CU + (size_t)r * D) + ch); w0v[k] = *((const f32x4*)(cw + k * D) + 2 * ch); w1v[k] = *((const f32x4*)(cw + k * D) + 2 * ch + 1); }
        const u32x4 b = *((const u32x4*)(Bg + (size_t)row * D) + ch);
        __builtin_amdgcn_sched_barrier(0);
#pragma unroll
        for (int k = 0; k < 3; ++k) { const int r = row + k - 1; const float m = (r >= CTX && r < MT) ? 1.f : 0.f; const u32x4 c = cv[k]; const f32x4 w0 = w0v[k] * m, w1 = w1v[k] * m;
            z[0] += w0.x * bf_lo(c.x); z[1] += w0.y * bf_hi(c.x); z[2] += w0.z * bf_lo(c.y); z[3] += w0.w * bf_hi(c.y);
            z[4] += w1.x * bf_lo(c.z); z[5] += w1.y * bf_hi(c.z); z[6] += w1.z * bf_lo(c.w); z[7] += w1.w * bf_hi(c.w); }
        u32x4 w; w.x = pk2(z[0] * bf_lo(b.x), z[1] * bf_hi(b.x)); w.y = pk2(z[2] * bf_lo(b.y), z[3] * bf_hi(b.y));
        w.z = pk2(z[4] * bf_lo(b.z), z[5] * bf_hi(b.z)); w.w = pk2(z[6] * bf_lo(b.w), z[7] * bf_hi(b.w));
        *((u32x4*)(G + (size_t)row * D) + ch) = w;
    }
}

template <int DQK, int DV, bool NA>
__device__ __forceinline__ void attn_phase(LAS unsigned char* lds, const bf16_t* __restrict__ Q, const bf16_t* __restrict__ Kf, const bf16_t* __restrict__ VT,
                                           bf16_t* __restrict__ O, const float* __restrict__ rpb, int H, bool with_ctx) {
    constexpr int KSTR = (DQK + 8) * 2, VSTR = (64 + 8) * 2, KBUF = 64 * KSTR, VBUF = DV * VSTR;
    constexpr int KCH = DQK / 8, NKL = 64 * KCH / NTHR, NVL = DV * 8 / NTHR, NKS = DQK / 16, NDV = DV / 32;
    constexpr int RPB_OFF = 2 * KBUF + 2 * VBUF;
    const int tid = opaque_tid(), wave = tid >> 6, lane = tid & 63, r = lane & 31, hh = lane >> 5;
    LAS float* rpbL = (LAS float*)(lds + RPB_OFF);
    const int nbig = 64 * H, nunits = with_ctx ? 65 * H : 64 * H;
    for (int u = blockIdx.x; u < nunits; u += gridDim.x) {
        int head, qb;
        if (u < nbig) { const int b = u & 255, rnd = u >> 8, xcd = b & 7, slot = b >> 3; head = xcd + 8 * (rnd >> 1); qb = 1 + (rnd & 1) * 32 + slot; }
        else { head = u - nbig; qb = 0; }
        int nloc = 0, rlo = 0, NT;
        if (!NA) NT = (qb == 0) ? 4 : 260;
        else { if (qb > 0) { const int r0 = 4 * (qb - 1); rlo = min(max(r0 - 4, 0), 248); const int rhi = min(max(r0 - 1, 0), 248) + 7; nloc = rhi - rlo + 1; } NT = nloc + 4; }
#define TILE_ROW0(t) (!NA ? 64 * (t) : ((t) < nloc ? CTX + 64 * (rlo + (t)) : 64 * ((t) - nloc)))
        const int qrow = 256 * qb + 32 * wave + r;
        const int rq = 4 * (qb - 1) + (wave >> 1), cq = 32 * (wave & 1) + r;
        const int rs = min(max(rq - 4, 0), 248), cs = min(max(cq - 8, 0), 48);
        bf16x8 qf[NKS];
#pragma unroll
        for (int ks = 0; ks < NKS; ++ks) qf[ks] = *(const bf16x8*)(Q + ((size_t)head * MT + qrow) * DQK + 16 * ks + 8 * hh);
        u32x4 kreg[NKL], vreg[NVL];
#define ATT_LOAD(t) do { const int row0_ = TILE_ROW0(t); \
        _Pragma("unroll") for (int i = 0; i < NKL; ++i) { const int c_ = tid + NTHR * i, kr_ = c_ / KCH, kc_ = c_ % KCH; kreg[i] = *(const u32x4*)(Kf + ((size_t)head * MT + row0_ + kr_) * DQK + kc_ * 8); } \
        _Pragma("unroll") for (int i = 0; i < NVL; ++i) { const int c_ = tid + NTHR * i, vr_ = c_ >> 3, vc_ = c_ & 7; vreg[i] = *(const u32x4*)(VT + (size_t)(head * DV + vr_) * MT + row0_ + vc_ * 8); } } while (0)
#define ATT_STORE(buf) do { \
        _Pragma("unroll") for (int i = 0; i < NKL; ++i) { const int c_ = tid + NTHR * i, kr_ = c_ / KCH, kc_ = c_ % KCH; *(LAS u32x4*)(lds + (buf) * KBUF + kr_ * KSTR + kc_ * 16) = kreg[i]; } \
        _Pragma("unroll") for (int i = 0; i < NVL; ++i) { const int c_ = tid + NTHR * i, vr_ = c_ >> 3, vc_ = c_ & 7; *(LAS u32x4*)(lds + 2 * KBUF + (buf) * VBUF + vr_ * VSTR + vc_ * 16) = vreg[i]; } } while (0)
        ATT_LOAD(0); ATT_STORE(0);
        if (NA) { for (int i = tid; i < 15 * 31; i += NTHR) rpbL[i] = rpb[head * (15 * 31) + i] * LOG2E; }
        __syncthreads();
        float mrun = -INFINITY, lsum = 0.f;
        f32x16 o[NDV];
#pragma unroll
        for (int d = 0; d < NDV; ++d)
#pragma unroll
            for (int i = 0; i < 16; ++i) o[d][i] = 0.f;
        for (int t = 0; t < NT; ++t) {
            const int cur = t & 1;
            if (t + 1 < NT) ATT_LOAD(t + 1);
            bool active = true; int rr = 0; const bool local = NA && (t < nloc);
            if (local) { rr = rlo + t; active = (rr >= rs) && (rr < rs + 8); }
            if (active) {
                f32x16 s[2];
#pragma unroll
                for (int kb = 0; kb < 2; ++kb) {
#pragma unroll
                    for (int i = 0; i < 16; ++i) s[kb][i] = 0.f;
#pragma unroll
                    for (int ks = 0; ks < NKS; ++ks) {
                        const bf16x8 a = *(const LAS bf16x8*)(lds + cur * KBUF + (32 * kb + r) * KSTR + (16 * ks + 8 * hh) * 2);
                        s[kb] = __builtin_amdgcn_mfma_f32_32x32x16_bf16(a, qf[ks], s[kb], 0, 0, 0);
                    }
                }
                if (local) {
                    const int dr = rr - rq + 7;
#pragma unroll
                    for (int kb = 0; kb < 2; ++kb)
#pragma unroll
                        for (int i = 0; i < 16; ++i) { const int kc = 32 * kb + (i & 3) + 8 * (i >> 2) + 4 * hh; const bool valid = (kc >= cs) && (kc < cs + 16);
                            const int dc = min(max(kc - cq + 15, 0), 30);
                            const float bias = rpbL[dr * 31 + dc];
                            s[kb][i] = valid ? s[kb][i] + bias : -INFINITY; }
                }
                float mx = s[0][0];
#pragma unroll
                for (int i = 1; i < 16; ++i) mx = fmaxf(mx, s[0][i]);
#pragma unroll
                for (int i = 0; i < 16; ++i) mx = fmaxf(mx, s[1][i]);
                mx = fmaxf(mx, __shfl_xor(mx, 32));
                const float mnew = fmaxf(mrun, mx), alpha = __builtin_amdgcn_exp2f(mrun - mnew);
                mrun = mnew;
                float ps = 0.f;
#pragma unroll
                for (int kb = 0; kb < 2; ++kb)
#pragma unroll
                    for (int i = 0; i < 16; ++i) { s[kb][i] = __builtin_amdgcn_exp2f(s[kb][i] - mnew); ps += s[kb][i]; }
                lsum = lsum * alpha + ps;
#pragma unroll
                for (int d = 0; d < NDV; ++d)
#pragma unroll
                    for (int i = 0; i < 16; ++i) o[d][i] *= alpha;
#pragma unroll
                for (int kb = 0; kb < 2; ++kb)
#pragma unroll
                    for (int sx = 0; sx < 2; ++sx) {
                        u32x4 pw; pw.x = pk2(s[kb][8 * sx + 0], s[kb][8 * sx + 1]); pw.y = pk2(s[kb][8 * sx + 2], s[kb][8 * sx + 3]);
                        pw.z = pk2(s[kb][8 * sx + 4], s[kb][8 * sx + 5]); pw.w = pk2(s[kb][8 * sx + 6], s[kb][8 * sx + 7]);
                        const bf16x8 pb = __builtin_bit_cast(bf16x8, pw);
#pragma unroll
                        for (int d = 0; d < NDV; ++d) {
                            const LAS unsigned char* vp = lds + 2 * KBUF + cur * VBUF + (32 * d + r) * VSTR + (32 * kb + 16 * sx + 4 * hh) * 2;
                            const u32x2 v0 = *(const LAS u32x2*)vp, v1 = *(const LAS u32x2*)(vp + 16);
                            u32x4 vw; vw.x = v0.x; vw.y = v0.y; vw.z = v1.x; vw.w = v1.y;
                            o[d] = __builtin_amdgcn_mfma_f32_32x32x16_bf16(__builtin_bit_cast(bf16x8, vw), pb, o[d], 0, 0, 0);
                        }
                    }
            }
            if (t + 1 < NT) ATT_STORE(cur ^ 1);
            __syncthreads();
        }
        const float ltot = lsum + __shfl_xor(lsum, 32), inv = 1.f / ltot;
        bf16_t* orow = O + (size_t)qrow * (H * DV) + head * DV;
#pragma unroll
        for (int d = 0; d < NDV; ++d)
#pragma unroll
            for (int g = 0; g < 4; ++g) { u32x2 w; w.x = pk2(o[d][4 * g] * inv, o[d][4 * g + 1] * inv); w.y = pk2(o[d][4 * g + 2] * inv, o[d][4 * g + 3] * inv);
                *(u32x2*)(orow + 32 * d + 8 * g + 4 * hh) = w; }
#undef ATT_LOAD
#undef ATT_STORE
#undef TILE_ROW0
    }
}

__device__ __forceinline__ void attn_na16_phase(LAS unsigned char* lds, const bf16_t* __restrict__ Q, const bf16_t* __restrict__ Kf, const bf16_t* __restrict__ VT, bf16_t* __restrict__ O,
                                                const float* __restrict__ rpb) {
    constexpr int H = 16, HD = 64, KSTR = 144, VSTR = 144, KBUF = 64 * KSTR, VBUF = 64 * VSTR, RPB_OFF = 2 * KBUF + 2 * VBUF;
    const int tid = opaque_tid(), wave = tid >> 6, lane = tid & 63, r = lane & 31, hh = lane >> 5;
    LAS float* rpbL = (LAS float*)(lds + RPB_OFF);
    const int cg_ = wave & 3, rp = wave >> 2, kc0 = min(max(16 * cg_ - 8, 0), 32);
    for (int u = blockIdx.x; u < 64 * H; u += gridDim.x) {
        const int b = u & 255, rnd = u >> 8, xcd = b & 7, slot = b >> 3, head = xcd + 8 * (rnd >> 1), qb = (rnd & 1) * 32 + slot;
        const int r0 = 4 * qb, rlo = min(max(r0 - 4, 0), 248), rhi = min(max(r0 - 1, 0), 248) + 7, nloc = rhi - rlo + 1, NT = nloc + 4;
        const int rq = r0 + 2 * rp + (r >> 4), cq = 16 * cg_ + (r & 15);
        const int rs = min(max(rq - 4, 0), 248), cs = min(max(cq - 8, 0), 48);
        const int wlo = min(max(r0 + 2 * rp - 4, 0), 248), whi = min(max(r0 + 2 * rp - 3, 0), 248) + 7;
        const int qrow = CTX + 64 * rq + cq;
        unsigned vmask = 0u;
#pragma unroll
        for (int i = 0; i < 16; ++i) { const int kc_ = kc0 + (i & 3) + 8 * (i >> 2) + 4 * hh; if (kc_ >= cs && kc_ < cs + 16) vmask |= 1u << i; }
        const int dcb = kc0 + 4 * hh - cq + 15;
        bf16x8 qf[4];
#pragma unroll
        for (int ks = 0; ks < 4; ++ks) qf[ks] = *(const bf16x8*)(Q + ((size_t)head * MT + qrow) * HD + 16 * ks + 8 * hh);
        u32x4 kreg, vreg;
#define NA_ROW0(t) ((t) < nloc ? CTX + 64 * (rlo + (t)) : 64 * ((t) - nloc))
#define NA_LOAD(t) do { const int row0_ = NA_ROW0(t); kreg = *(const u32x4*)(Kf + ((size_t)head * MT + row0_ + (tid >> 3)) * HD + (tid & 7) * 8); \
        vreg = *(const u32x4*)(VT + (size_t)(head * HD + (tid >> 3)) * MT + row0_ + (tid & 7) * 8); } while (0)
#define NA_STORE(buf) do { *(LAS u32x4*)(lds + (buf) * KBUF + (tid >> 3) * KSTR + (tid & 7) * 16) = kreg; *(LAS u32x4*)(lds + 2 * KBUF + (buf) * VBUF + (tid >> 3) * VSTR + (tid & 7) * 16) = vreg; } while (0)
        __syncthreads();
        NA_LOAD(0); NA_STORE(0);
        for (int i = tid; i < 15 * 31; i += NTHR) rpbL[64 + i] = rpb[head * (15 * 31) + i] * LOG2E;
        __syncthreads();
        float mrun = -INFINITY, lsum = 0.f;
        f32x16 o[2];
#pragma unroll
        for (int d = 0; d < 2; ++d)
#pragma unroll
            for (int i = 0; i < 16; ++i) o[d][i] = 0.f;
#define NA_BLOCK(koff, LOCAL) do { \
        f32x16 s_; \
        _Pragma("unroll") for (int i = 0; i < 16; ++i) s_[i] = 0.f; \
        _Pragma("unroll") for (int ks = 0; ks < 4; ++ks) { const bf16x8 a_ = *(const LAS bf16x8*)(kb_ + ((koff) + r) * KSTR + (16 * ks + 8 * hh) * 2); s_ = __builtin_amdgcn_mfma_f32_32x32x16_bf16(a_, qf[ks], s_, 0, 0, 0); } \
        if (LOCAL) { const bool rowok_ = (rr_ >= rs) && (rr_ < rs + 8); const LAS float* bp_ = rpbL + 64 + (rr_ - rq + 7) * 31 + dcb; \
            _Pragma("unroll") for (int i = 0; i < 16; ++i) { const float bias_ = bp_[(i & 3) + 8 * (i >> 2)]; s_[i] = (rowok_ && ((vmask >> i) & 1u)) ? s_[i] + bias_ : -INFINITY; } } \
        float mx_ = s_[0]; \
        _Pragma("unroll") for (int i = 1; i < 16; ++i) mx_ = fmaxf(mx_, s_[i]); \
        mx_ = fmaxf(mx_, __shfl_xor(mx_, 32)); \
        const float mnew_ = fmaxf(mrun, mx_), msafe_ = (mnew_ == -INFINITY) ? 0.f : mnew_, alpha_ = __builtin_amdgcn_exp2f(mrun - msafe_); mrun = mnew_; \
        float ps_ = 0.f; \
        _Pragma("unroll") for (int i = 0; i < 16; ++i) { s_[i] = __builtin_amdgcn_exp2f(s_[i] - msafe_); ps_ += s_[i]; } \
        lsum = lsum * alpha_ + ps_; \
        _Pragma("unroll") for (int d = 0; d < 2; ++d) _Pragma("unroll") for (int i = 0; i < 16; ++i) o[d][i] *= alpha_; \
        _Pragma("unroll") for (int sx = 0; sx < 2; ++sx) { \
            u32x4 pw_; pw_.x = pk2(s_[8 * sx + 0], s_[8 * sx + 1]); pw_.y = pk2(s_[8 * sx + 2], s_[8 * sx + 3]); pw_.z = pk2(s_[8 * sx + 4], s_[8 * sx + 5]); pw_.w = pk2(s_[8 * sx + 6], s_[8 * sx + 7]); \
            const bf16x8 pb_ = __builtin_bit_cast(bf16x8, pw_); \
            _Pragma("unroll") for (int d = 0; d < 2; ++d) { const LAS unsigned char* vp_ = vb_ + (32 * d + r) * VSTR + ((koff) + 16 * sx + 4 * hh) * 2; \
                const u32x2 v0_ = *(const LAS u32x2*)vp_, v1_ = *(const LAS u32x2*)(vp_ + 16); u32x4 vw_; vw_.x = v0_.x; vw_.y = v0_.y; vw_.z = v1_.x; vw_.w = v1_.y; \
                o[d] = __builtin_amdgcn_mfma_f32_32x32x16_bf16(__builtin_bit_cast(bf16x8, vw_), pb_, o[d], 0, 0, 0); } } } while (0)
        for (int t = 0; t < NT; ++t) {
            const int cur = t & 1;
            if (t + 1 < NT) NA_LOAD(t + 1);
            const LAS unsigned char* kb_ = lds + cur * KBUF; const LAS unsigned char* vb_ = lds + 2 * KBUF + cur * VBUF;
            const int rr_ = rlo + t;
            if (t < nloc) { if (rr_ >= wlo && rr_ <= whi) NA_BLOCK(kc0, true); }
            else { NA_BLOCK(0, false); NA_BLOCK(32, false); }
            if (t + 1 < NT) NA_STORE(cur ^ 1);
            __syncthreads();
        }
        const float ltot = lsum + __shfl_xor(lsum, 32), inv = 1.f / ltot;
        bf16_t* orow = O + (size_t)qrow * (H * HD) + head * HD;
#pragma unroll
        for (int d = 0; d < 2; ++d)
#pragma unroll
            for (int g = 0; g < 4; ++g) { u32x2 w; w.x = pk2(o[d][4 * g] * inv, o[d][4 * g + 1] * inv); w.y = pk2(o[d][4 * g + 2] * inv, o[d][4 * g + 3] * inv);
                *(u32x2*)(orow + 32 * d + 8 * g + 4 * hh) = w; }
#undef NA_ROW0
#undef NA_LOAD
#undef NA_STORE
#undef NA_BLOCK
    }
}

__device__ __forceinline__ int swap23(int r) { return (r & ~12) | ((r & 4) << 1) | ((r & 8) >> 1); }
struct MlaOff { int ko1[8], ko2[4], vo[4]; };
constexpr int MLA_K1 = 0, MLA_K2 = 49152, MLA_V = 73728;
template <int SLOT, int KB> __device__ __forceinline__ void mla_s1(f32x16& sd, const f32x16& cinit, LAS unsigned char* lds, const MlaOff& F, const bf16x8 (&qf)[12]) {
    { const bf16x8 a = *(const LAS bf16x8*)(lds + F.ko1[0] + (SLOT * 16384 + KB * 8192)); sd = __builtin_amdgcn_mfma_f32_32x32x16_bf16(a, qf[0], cinit, 0, 0, 0); }
#pragma unroll
    for (int ks = 1; ks < 8; ++ks) { const bf16x8 a = *(const LAS bf16x8*)(lds + F.ko1[ks] + (SLOT * 16384 + KB * 8192)); sd = __builtin_amdgcn_mfma_f32_32x32x16_bf16(a, qf[ks], sd, 0, 0, 0); }
#pragma unroll
    for (int ks = 0; ks < 4; ++ks) { const bf16x8 a = *(const LAS bf16x8*)(lds + F.ko2[ks] + (SLOT * 8192 + KB * 4096)); sd = __builtin_amdgcn_mfma_f32_32x32x16_bf16(a, qf[8 + ks], sd, 0, 0, 0); }
}
template <int VS, int KB, int NS, int NKB>
__device__ __forceinline__ void mla_step(f32x16& sc, f32x16& sn, f32x16 (&o)[4], f32x16& negm, float& lsum, float& mxc, LAS unsigned char* lds, const MlaOff& F, const bf16x8 (&qf)[12]) {
    if (__any(mxc > 0.f)) { const float dlt = fmaxf(mxc, 0.f), alpha = __builtin_amdgcn_exp2f(-dlt); lsum *= alpha;
#pragma unroll
        for (int i = 0; i < 16; ++i) { negm[i] -= dlt; sc[i] -= dlt; }
#pragma unroll
        for (int d = 0; d < 4; ++d)
#pragma unroll
            for (int i = 0; i < 16; ++i) o[d][i] *= alpha; }
    mla_s1<NS, NKB>(sn, negm, lds, F, qf);
    float ps = 0.f;
#pragma unroll
    for (int i = 0; i < 16; ++i) { sc[i] = __builtin_amdgcn_exp2f(sc[i]); ps += sc[i]; }
    lsum += ps;
#pragma unroll
    for (int sx = 0; sx < 2; ++sx) {
        u32x4 pw; pw.x = pk2(sc[8 * sx + 0], sc[8 * sx + 1]); pw.y = pk2(sc[8 * sx + 2], sc[8 * sx + 3]); pw.z = pk2(sc[8 * sx + 4], sc[8 * sx + 5]); pw.w = pk2(sc[8 * sx + 6], sc[8 * sx + 7]);
        const bf16x8 pb = __builtin_bit_cast(bf16x8, pw);
#pragma unroll
        for (int d = 0; d < 4; ++d) { const bf16x8 va = *(const LAS bf16x8*)(lds + F.vo[2 * KB + sx] + (VS * 16384 + d * 4096)); o[d] = __builtin_amdgcn_mfma_f32_32x32x16_bf16(va, pb, o[d], 0, 0, 0); } }
    float mx = sn[0];
#pragma unroll
    for (int i = 1; i < 16; ++i) mx = fmaxf(mx, sn[i]);
    mxc = fmaxf(mx, __shfl_xor(mx, 32));
}
__device__ __forceinline__ void attn_mla_phase(LAS unsigned char* lds, const bf16_t* __restrict__ Q, const bf16_t* __restrict__ Kf, const bf16_t* __restrict__ VT, bf16_t* __restrict__ O) {
    constexpr int H = 8, DQK = 192, DV = 128;
    const int tid = opaque_tid(), wave = __builtin_amdgcn_readfirstlane(tid >> 6), lane = tid & 63, r = lane & 31, hh = lane >> 5;
    unsigned goff[5], lbase[5], lstr[5]; bool isv[5];
#pragma unroll
    for (int i = 0; i < 5; ++i) {
        const int j = wave * 5 + i;
        if (j < 16) { const int q = j * 64 + lane, key = q >> 4, c = (q & 15) ^ (key & 15); goff[i] = key * DQK + c * 8; lbase[i] = MLA_K1 + j * 1024; lstr[i] = 16384; isv[i] = false; }
        else if (j < 24) { const int q = (j - 16) * 64 + lane, row = q >> 4, cc = (q & 15) ^ (row & 15), key = 2 * row + (cc >> 3); goff[i] = key * DQK + 128 + (cc & 7) * 8; lbase[i] = MLA_K2 + (j - 16) * 1024; lstr[i] = 8192; isv[i] = false; }
        else { const int q = (j - 24) * 64 + lane, row2 = q >> 4, cc = (q & 15) ^ (row2 & 15), dv = 2 * row2 + (cc >> 3); goff[i] = dv * MT + (cc & 7) * 8; lbase[i] = MLA_V + (j - 24) * 1024; lstr[i] = 16384; isv[i] = true; }
    }
    MlaOff F;
    { const int pr = swap23(r), kx = pr & 15, k1row = pr * 256, k2row = (pr >> 1) * 256, k2cb = (pr & 1) * 8, k2x = (pr >> 1) & 15, vrow = (r >> 1) * 256, vcb = (r & 1) * 8, vx = (r >> 1) & 15;
#pragma unroll
      for (int ks = 0; ks < 8; ++ks) F.ko1[ks] = MLA_K1 + k1row + (((2 * ks + hh) ^ kx) << 4);
#pragma unroll
      for (int ks = 0; ks < 4; ++ks) F.ko2[ks] = MLA_K2 + k2row + (((k2cb + 2 * ks + hh) ^ k2x) << 4);
#pragma unroll
      for (int c = 0; c < 4; ++c) F.vo[c] = MLA_V + vrow + (((vcb + 2 * c + hh) ^ vx) << 4); }
    const int nbig = 64 * H, nunits = 65 * H;
    for (int u = blockIdx.x; u < nunits; u += gridDim.x) {
        int head, qb;
        if (u < nbig) { const int b = u & 255, rnd = u >> 8, xcd = b & 7, slot = b >> 3; head = xcd + 8 * (rnd >> 1); qb = 1 + (rnd & 1) * 32 + slot; }
        else { head = u - nbig; qb = 0; }
        const int NT = (qb == 0) ? 4 : 260;
        const int qrow = 256 * qb + 32 * wave + r;
        bf16x8 qf[12];
#pragma unroll
        for (int ks = 0; ks < 12; ++ks) qf[ks] = *(const bf16x8*)(Q + ((size_t)head * MT + qrow) * DQK + 16 * ks + 8 * hh);
        const bf16_t* kbase = Kf + (size_t)head * MT * DQK; const bf16_t* vbase = VT + (size_t)head * DV * MT;
#define MLA_ISSUE(s, SL) do { const bf16_t* kb_ = kbase + (size_t)(s) * 64 * DQK; const bf16_t* vb_ = vbase + (size_t)(s) * 64; \
        _Pragma("unroll") for (int i = 0; i < 5; ++i) __builtin_amdgcn_global_load_lds((const unsigned*)((isv[i] ? vb_ : kb_) + goff[i]), (LAS unsigned*)(lds + lbase[i] + (SL) * lstr[i]), 16, 0, 0); } while (0)
#define MLA_WAITBAR() do { asm volatile("s_waitcnt vmcnt(0)" ::: "memory"); __builtin_amdgcn_s_barrier(); asm volatile("" ::: "memory"); } while (0)
#define MLA_TILE(t, SL) do { \
        mla_step<SL, 0, SL, 1>(sA, sB, o, negm, lsum, mxc, lds, F, qf); \
        if ((t) + 2 < NT) MLA_ISSUE((t) + 2, ((SL) + 2) % 3); \
        mla_step<SL, 1, ((SL) + 1) % 3, 0>(sB, sA, o, negm, lsum, mxc, lds, F, qf); \
        MLA_WAITBAR(); } while (0)
        float lsum = 0.f, mxc;
        f32x16 o[4], sA, sB, negm;
#pragma unroll
        for (int d = 0; d < 4; ++d)
#pragma unroll
            for (int i = 0; i < 16; ++i) o[d][i] = 0.f;
        MLA_ISSUE(0, 0); MLA_ISSUE(1, 1);
        MLA_WAITBAR();
        { f32x16 z;
#pragma unroll
          for (int i = 0; i < 16; ++i) z[i] = 0.f;
          mla_s1<0, 0>(sA, z, lds, F, qf);
          float mx_ = sA[0];
#pragma unroll
          for (int i = 1; i < 16; ++i) mx_ = fmaxf(mx_, sA[i]);
          mx_ = fmaxf(mx_, __shfl_xor(mx_, 32));
#pragma unroll
          for (int i = 0; i < 16; ++i) { negm[i] = -mx_; sA[i] -= mx_; }
          mxc = 0.f; }
        int t = 0;
        for (; t + 3 <= NT; t += 3) { MLA_TILE(t, 0); MLA_TILE(t + 1, 1); MLA_TILE(t + 2, 2); }
        if (t < NT) { MLA_TILE(t, 0); if (t + 1 < NT) MLA_TILE(t + 1, 1); }
        const float ltot = lsum + __shfl_xor(lsum, 32), inv = 1.f / ltot;
        bf16_t* orow = O + (size_t)qrow * (H * DV) + head * DV;
#pragma unroll
        for (int d = 0; d < 4; ++d)
#pragma unroll
            for (int g = 0; g < 4; ++g) { u32x2 w; w.x = pk2(o[d][4 * g] * inv, o[d][4 * g + 1] * inv); w.y = pk2(o[d][4 * g + 2] * inv, o[d][4 * g + 3] * inv);
                *(u32x2*)(orow + 32 * d + 8 * g + 4 * hh) = w; }
#undef MLA_ISSUE
#undef MLA_WAITBAR
#undef MLA_TILE
    }
}

struct Args { const float* in[30]; float* out; unsigned char* ws; int ph_lo, ph_hi; };

typedef const __attribute__((address_space(4))) Args* ArgsP;
__device__ __forceinline__ ArgsP get_args() { ArgsP p = (ArgsP)__builtin_amdgcn_kernarg_segment_ptr(); asm volatile("" : "+s"(p)); return p; }
#define WSP(T, off) ((T*)(ws + (off)))

#define PHASE_BEGIN if (ph >= lo && ph < hi) { ArgsP ap = get_args(); unsigned char* ws = ap->ws; (void)ws;
#define PHASE_END   if (ph + 1 < hi) xcd_barrier(bar); } ++ph;
#define P_X WSP(float, WS_X)
#define P_H WSP(bf16_t, WS_H)
#define P_BIG WSP(bf16_t, WS_BIG)
#define P_MIX WSP(bf16_t, WS_MIX)
#define P_QF WSP(bf16_t, WS_QF)
#define P_KF WSP(bf16_t, WS_KF)
#define P_VT WSP(bf16_t, WS_VT)
#define P_MODL (WSP(float, WS_MOD) + (size_t)L * 2 * 9216)
template <int L>
__device__ __forceinline__ void layer_body(const XcdBarrier& bar, LAS unsigned char* lds, int& ph, const int lo, const int hi) {
    constexpr bool CTX_A = (L <= 2);
    constexpr bool CTX_B = (L <= 1);
    constexpr int RB_A = CTX_A ? 0 : CTX, M_A = CTX_A ? MT : SEQ;
    constexpr int RB_B = CTX_B ? 0 : CTX, M_B = CTX_B ? MT : SEQ;
    PHASE_BEGIN for (int rep = 0; rep < REP_NORM; ++rep) norm_phase((L == 0) ? ap->in[2] : P_X, (L == 0) ? ap->in[0] : P_X + (size_t)CTX * D, P_H, P_MODL, 0, 1, RB_A); PHASE_END
    PHASE_BEGIN for (int rep = 0; rep < REP_FFNIN; ++rep) { EpiSwiglu E{P_BIG, DFF, RB_A}; run_gemm(lds, P_H + (size_t)RB_A * D, WSP(bf16_t, WS_WIN) + (size_t)(2 * L) * 5632 * 1024, M_A, 2 * DFF, D, E, 0); } PHASE_END
    PHASE_BEGIN {
        const bf16_t* W = WSP(bf16_t, WS_WOUT) + (size_t)(2 * L) * 1024 * 2816;
        for (int rep = 1; rep < REP_FFNOUT; ++rep) { EpiResid E{P_X, WSP(float, WS_QF), P_MODL + 9216 + 2 * D, 0.5f, CTX, CTX, 0}; run_gemm(lds, P_BIG + (size_t)CTX * DFF, W, SEQ, D, DFF, E, 0); }
        { EpiResid E{(L == 0) ? ap->in[0] : P_X, P_X, P_MODL + 9216 + 2 * D, 0.5f, CTX, 0, (L == 0) ? CTX : 0}; run_gemm(lds, P_BIG + (size_t)CTX * DFF, W, SEQ, D, DFF, E, 0); }
        if (CTX_A) ctx_resid<DFF>(lds, P_BIG, W, (L == 0) ? ap->in[2] : P_X, P_X, P_MODL + 2 * D, 0.5f);
    } PHASE_END
    PHASE_BEGIN for (int rep = 0; rep < REP_NORM; ++rep) norm_phase(P_X, P_X + (size_t)CTX * D, P_H, P_MODL, 3, 4, RB_A); PHASE_END
    if (L == 0) {
        PHASE_BEGIN { EpiStore E{WSP(bf16_t, WS_DQKV), 768, 0}; run_gemm(lds, P_H, WSP(bf16_t, WS_MLA_DQKV), MT, 768, D, E, 0); } PHASE_END
        PHASE_BEGIN mla_na_phase(WSP(bf16_t, WS_DQKV), WSP(bf16_t, WS_CQN), WSP(bf16_t, WS_CKVN), P_KF, ap->in[9], ap->in[12], ap->in[18]); PHASE_END
        PHASE_BEGIN {
            { EpiStore E{P_BIG, 1536, 0}; run_gemm(lds, WSP(bf16_t, WS_CQN), WSP(bf16_t, WS_MLA_UQ), MT, 1536, 384, E, 0); }
            { EpiStore E{P_BIG + (size_t)MT * 1536, 1024, 0}; run_gemm(lds, WSP(bf16_t, WS_CKVN), WSP(bf16_t, WS_MLA_UK), MT, 1024, 256, E, 134); }
            { EpiStore E{P_VT, MT, 0}; run_gemm(lds, WSP(bf16_t, WS_MLA_UVT), WSP(bf16_t, WS_CKVN), 1024, MT, 256, E, 138); }
        } PHASE_END
        PHASE_BEGIN mla_nb_phase(P_BIG, P_BIG + (size_t)MT * 1536, P_QF, P_KF, ap->in[15], ap->in[16], ap->in[17], 0.07216878364870322f * LOG2E); PHASE_END
        PHASE_BEGIN attn_mla_phase(lds, P_QF, P_KF, P_VT, P_MIX); PHASE_END
    } else if (L == 1) {
        PHASE_BEGIN pool_phase(P_H, P_MIX); PHASE_END
    } else if (L == 2) {
        PHASE_BEGIN {
            { EpiNaQK E{P_QF, P_KF, ap->in[23], ap->in[24], 0.125f * LOG2E}; run_gemm(lds, P_H, WSP(bf16_t, WS_NA_QK), MT, 2048, D, E, 0); }
            { EpiStore E{P_VT, MT, 0}; run_gemm(lds, WSP(bf16_t, WS_NA_VT), P_H, 1024, MT, D, E, 8); }
        } PHASE_END
        PHASE_BEGIN attn_na16_phase(lds, P_QF, P_KF, P_VT, P_MIX, ap->in[25]); PHASE_END
    } else {
        PHASE_BEGIN {
            { EpiMulPair E{P_BIG, D, CTX}; run_gemm(lds, P_H + (size_t)CTX * D, WSP(bf16_t, WS_CV_IN), SEQ, 2048, D, E, 0); }
            { EpiStore E{P_BIG + (size_t)MT * D, D, CTX}; run_gemm(lds, P_H + (size_t)CTX * D, WSP(bf16_t, WS_CV_IN) + (size_t)2048 * D, SEQ, D, D, E, 0); }
        } PHASE_END
        PHASE_BEGIN conv_phase(P_BIG, P_BIG + (size_t)MT * D, P_MIX, ap->in[28]); PHASE_END
    }
    PHASE_BEGIN {
        const size_t wo_off = (L == 0) ? WS_MLA_O : (L == 1) ? WS_POOL : (L == 2) ? WS_NA_O : WS_CV_OUT;
        if (L == 1) {
#pragma unroll
            for (int g = 0; g < 4; ++g) { EpiResid E{P_X + g * 256, P_X + g * 256, P_MODL + 9216 + 5 * D + g * 256, 1.0f, CTX, 0, 0};
                run_gemm(lds, P_MIX + ((size_t)g * MT + CTX) * 256, WSP(bf16_t, WS_POOL) + (size_t)g * 65536, SEQ, 256, 256, E, 64 * g); }
            ctx_resid_pool(lds, P_MIX, WSP(bf16_t, WS_POOL), P_X, P_MODL + 5 * D);
        } else {
        { EpiResid E{P_X, P_X, P_MODL + 9216 + 5 * D, 1.0f, CTX, 0, 0}; run_gemm(lds, P_MIX + (size_t)CTX * D, WSP(bf16_t, wo_off), SEQ, D, D, E, 0); }
        if (CTX_B) ctx_resid<D>(lds, P_MIX, WSP(bf16_t, wo_off), P_X, P_X, P_MODL + 5 * D, 1.0f);
        }
    } PHASE_END
    PHASE_BEGIN for (int rep = 0; rep < REP_NORM; ++rep) norm_phase(P_X, P_X + (size_t)CTX * D, P_H, P_MODL, 6, 7, RB_B); PHASE_END
    PHASE_BEGIN for (int rep = 0; rep < REP_FFNIN; ++rep) { EpiSwiglu E{P_BIG, DFF, RB_B}; run_gemm(lds, P_H + (size_t)RB_B * D, WSP(bf16_t, WS_WIN) + (size_t)(2 * L + 1) * 5632 * 1024, M_B, 2 * DFF, D, E, 0); } PHASE_END
    PHASE_BEGIN {
        const bf16_t* W = WSP(bf16_t, WS_WOUT) + (size_t)(2 * L + 1) * 1024 * 2816;
        { EpiResid E{P_X, (L == 3) ? ap->out : P_X, P_MODL + 9216 + 8 * D, 0.5f, CTX, (L == 3) ? CTX : 0, 0}; run_gemm(lds, P_BIG + (size_t)CTX * DFF, W, SEQ, D, DFF, E, 0); }
        if (CTX_B) ctx_resid<DFF>(lds, P_BIG, W, P_X, P_X, P_MODL + 8 * D, 0.5f);
    } if (L < 3 && ph + 1 < hi) xcd_barrier(bar); } ++ph;
}
__global__ void __launch_bounds__(NTHR, 2) fwd_megakernel(Args args_unused) {
    extern __shared__ __attribute__((aligned(16))) unsigned char lds_raw[];
    LAS unsigned char* lds = (LAS unsigned char*)lds_raw;
    cg::grid_group grid = cg::this_grid();
    int lo, hi; unsigned* barw; { ArgsP ap0 = get_args(); lo = ap0->ph_lo; hi = ap0->ph_hi; barw = (unsigned*)(ap0->ws + WS_BAR); }
    if (lo > hi) grid.sync();
    volatile LAS unsigned* bst = (volatile LAS unsigned*)(lds + 131072);
    if (threadIdx.x < 4) bst[threadIdx.x] = 0u;
    __syncthreads();
    const XcdBarrier bar = xcd_barrier_post(barw, bst);
    int ph = 0;

    PHASE_BEGIN
    for (int rep = 0; rep < REP_P0; ++rep) {
        const int tid = opaque_tid(), lane = tid & 63, wave = tid >> 6;
        bf16_t* WIN = WSP(bf16_t, WS_WIN); bf16_t* WOUT = WSP(bf16_t, WS_WOUT); bf16_t* W_DQKV = WSP(bf16_t, WS_MLA_DQKV); bf16_t* W_POOL = WSP(bf16_t, WS_POOL);
        ConvCtx c; c.base = 0; c.gw = blockIdx.x * NWAVE + wave; c.ngw = gridDim.x * NWAVE; c.lane = lane; c.scr = (LAS float*)(lds + wave * 16384);
        for (int lf = 0; lf < 8; ++lf) {
            conv_job(c, ap->in[6] + (size_t)lf * 1024 * 5632, 5632, 1024, 0, 5632, WIN + (size_t)lf * 5632 * 1024, 1024, 0, 0, nullptr, 1);
            conv_job(c, ap->in[7] + (size_t)lf * 2816 * 1024, 1024, 2816, 0, 1024, WOUT + (size_t)lf * 1024 * 2816, 2816, 0, 0, nullptr, 0);
        }
        conv_job(c, ap->in[8], 384, 1024, 0, 384, W_DQKV, 1024, 0, 0, nullptr, 0);
        conv_job(c, ap->in[11], 320, 1024, 0, 320, W_DQKV, 1024, 384, 0, nullptr, 0);
        conv_job(c, ap->in[10], 1536, 384, 0, 1536, WSP(bf16_t, WS_MLA_UQ), 384, 0, 0, nullptr, 0);
        conv_job(c, ap->in[13], 1024, 256, 0, 1024, WSP(bf16_t, WS_MLA_UK), 256, 0, 0, nullptr, 0);
        conv_job(c, ap->in[14], 1024, 256, 0, 1024, WSP(bf16_t, WS_MLA_UVT), 256, 0, 0, nullptr, 0);
        conv_job(c, ap->in[19], 1024, 1024, 0, 1024, WSP(bf16_t, WS_MLA_O), 1024, 0, 0, nullptr, 0);
        for (int g = 0; g < 4; ++g) conv_job(c, ap->in[20] + (size_t)g * 65536, 256, 256, 0, 256, W_POOL + (size_t)g * 65536, 256, 0, 0, ap->in[21] + g * 256, 0);
        conv_job(c, ap->in[22], 3072, 1024, 0, 2048, WSP(bf16_t, WS_NA_QK), 1024, 0, 0, nullptr, 2);
        conv_job(c, ap->in[22], 3072, 1024, 2048, 1024, WSP(bf16_t, WS_NA_VT), 1024, 0, 0, nullptr, 0);
        conv_job(c, ap->in[26], 1024, 1024, 0, 1024, WSP(bf16_t, WS_NA_O), 1024, 0, 0, nullptr, 0);
        conv_job(c, ap->in[27], 3072, 1024, 1024, 2048, WSP(bf16_t, WS_CV_IN), 1024, 0, 0, nullptr, 3);
        conv_job(c, ap->in[27], 3072, 1024, 0, 1024, WSP(bf16_t, WS_CV_IN), 1024, 2048, 0, nullptr, 0);
        conv_job(c, ap->in[29], 1024, 1024, 0, 1024, WSP(bf16_t, WS_CV_OUT), 1024, 0, 0, nullptr, 0);
        const long gt = (long)blockIdx.x * NTHR + tid, nt = (long)gridDim.x * NTHR;
        for (long i = gt; i < 64 * 128; i += nt) *((u32x4*)(W_DQKV + (size_t)704 * 1024) + i) = (u32x4){0u, 0u, 0u, 0u};
        const float* mw = ap->in[4]; const float* cctx = ap->in[3]; const float* clat = ap->in[1]; const float* mb = ap->in[5]; float* MOD = WSP(float, WS_MOD);
        for (int it = blockIdx.x; it < 256; it += gridDim.x) {
            const int l = it >> 6, col0 = (it & 63) * 144, k0 = 128 * wave;
            f32x4 ac = (f32x4){0.f, 0.f, 0.f, 0.f}, al = (f32x4){0.f, 0.f, 0.f, 0.f};
            if (lane < 36) {
                const float* w = mw + ((size_t)l * 1024 + k0) * 9216 + col0 + 4 * lane;
#pragma unroll 8
                for (int k = 0; k < 128; ++k) { const f32x4 wv = *(const f32x4*)(w + (size_t)k * 9216);
                    const float cc = cctx[k0 + k], cl = clat[k0 + k];
                    const float sc = cc / (1.f + __expf(-cc)), sl = cl / (1.f + __expf(-cl));
                    ac += wv * sc; al += wv * sl; }
                LAS float* pp = (LAS float*)(lds + wave * 16384 + 12288);
                *(LAS f32x4*)(pp + 4 * lane) = ac; *(LAS f32x4*)(pp + 144 + 4 * lane) = al;
            }
            __syncthreads();
            if (tid < 288) { const int sidx = tid / 144, c = tid % 144; float a = mb[l * 9216 + col0 + c];
#pragma unroll
                for (int w8 = 0; w8 < 8; ++w8) a += *(const LAS float*)(lds + w8 * 16384 + 12288 + (sidx * 144 + c) * 4);
                MOD[((size_t)l * 2 + sidx) * 9216 + col0 + c] = a; }
            __syncthreads();
        }
    }
    PHASE_END

    layer_body<0>(bar, lds, ph, lo, hi);
    layer_body<1>(bar, lds, ph, lo, hi);
    layer_body<2>(bar, lds, ph, lo, hi);
    layer_body<3>(bar, lds, ph, lo, hi);
}

extern "C" void kernel_launch(void* const* d_in, const int* in_sizes, int n_in, void* d_out, int out_size, void* d_ws, size_t ws_size, hipStream_t stream) {
    static int grid_blocks = 0;
    if (grid_blocks == 0) {
        if (n_in != 30 || out_size != SEQ * D || ws_size < WS_END) { fprintf(stderr, "kernel_launch: unexpected shapes (n_in %d out %d ws %zu need %zu)\n", n_in, out_size, ws_size, (size_t)WS_END); grid_blocks = -1; return; }
        int dev = 0, cus = 0, per_cu = 0;
        hipGetDevice(&dev);
        hipDeviceGetAttribute(&cus, hipDeviceAttributeMultiprocessorCount, dev);
        if (hipFuncSetAttribute((const void*)fwd_megakernel, hipFuncAttributeMaxDynamicSharedMemorySize, LDS_BYTES) != hipSuccess) { fprintf(stderr, "kernel_launch: hipFuncSetAttribute failed\n"); grid_blocks = -1; return; }
        if (hipOccupancyMaxActiveBlocksPerMultiprocessor(&per_cu, (const void*)fwd_megakernel, NTHR, LDS_BYTES) != hipSuccess || per_cu < 1) { fprintf(stderr, "kernel_launch: occupancy query failed (%d)\n", per_cu); per_cu = 1; (void)hipGetLastError(); }
        grid_blocks = cus * 1;
        (void)per_cu;
    }
    if (grid_blocks < 0) return;
    if (hipMemsetAsync((unsigned char*)d_ws + WS_BAR, 0, (size_t)XCD_BAR_WORDS * 4, stream) != hipSuccess) { fprintf(stderr, "kernel_launch: memset of the barrier words failed\n"); return; }
    Args a{};
    for (int i = 0; i < 30; ++i) a.in[i] = (const float*)d_in[i];
    a.out = (float*)d_out; a.ws = (unsigned char*)d_ws; a.ph_lo = 0; a.ph_hi = 1 << 20;
    void* kargs[] = {&a};
    hipError_t e = hipLaunchCooperativeKernel((const void*)fwd_megakernel, dim3(grid_blocks), dim3(NTHR), kargs, LDS_BYTES, stream);
    if (e != hipSuccess) fprintf(stderr, "kernel_launch: cooperative launch failed: %s (grid %d)\n", hipGetErrorString(e), grid_blocks);
}
```
